# Optimizing an MI355X kernel written in HIP

```python
import jax
import jax.numpy as jnp
from jax import lax
import numpy as np

D_MODEL = 2048
BATCH = 2
SEQ = 4096
DEPTH = 2
DEC_BATCH = 4
DEC_SEQ = 8192
PAST_LEN = 128

HEAD_DIM = 128
N_Q_HEADS = 16
N_KV_HEADS = 4
Q_PER_KV = N_Q_HEADS // N_KV_HEADS
WINDOW = 128
ATTN_BLOCK = 128
ROPE_THETA = 10000.0
SGU_WIDTH = D_MODEL
SGU_CHUNK = 128
SGU_GROUP_DIM = 128
SGU_GROUPS = SGU_WIDTH // SGU_GROUP_DIM
D_FF = 5632
Q_WIDTH = N_Q_HEADS * HEAD_DIM
KV_WIDTH = N_KV_HEADS * HEAD_DIM
OFF_Q = 0
OFF_K = OFF_Q + Q_WIDTH
OFF_V = OFF_K + KV_WIDTH
OFF_U = OFF_V + KV_WIDTH
OFF_SV = OFF_U + SGU_WIDTH
OFF_GA = OFF_SV + SGU_WIDTH
OFF_GB = OFF_GA + D_MODEL
IN_WIDTH = OFF_GB + D_MODEL
N_SUBLAYERS = 3
N_MOD = 3 * N_SUBLAYERS
DEEPNORM_ALPHA = (2 * DEPTH) ** 0.25
DEEPNORM_BETA = (8 * DEPTH) ** -0.25
MACARON_WEIGHT = 0.5
LN_EPS = 1e-5

kernel_name = 'hybrid_bidir_swa_sgu_macaron_encoder'


def layer_norm(x, g, b):
    xf = x.astype(jnp.float32)
    mu = jnp.mean(xf, axis=-1, keepdims=True)
    xc = xf - mu
    var = jnp.mean(xc * xc, axis=-1, keepdims=True)
    return (xc * lax.rsqrt(var + LN_EPS) * g + b).astype(x.dtype)


def rope(x):
    s = x.shape[1]
    half = HEAD_DIM // 2
    inv_freq = 1.0 / (ROPE_THETA ** (jnp.arange(half, dtype=jnp.float32) / half))
    ang = jnp.arange(s, dtype=jnp.float32)[:, None] * inv_freq[None, :]
    cos = jnp.cos(ang)[None, :, None, :]
    sin = jnp.sin(ang)[None, :, None, :]
    xf = x.astype(jnp.float32)
    x1, x2 = xf[..., :half], xf[..., half:]
    return jnp.concatenate([x1 * cos - x2 * sin, x2 * cos + x1 * sin], axis=-1).astype(x.dtype)


def band_blocks(t, nb):
    bsz = t.shape[0]
    tp = jnp.pad(t, ((0, 0), (ATTN_BLOCK, ATTN_BLOCK), (0, 0), (0, 0)))
    tp = tp.reshape(bsz, nb + 2, ATTN_BLOCK, t.shape[2], t.shape[3])
    return jnp.concatenate([tp[:, :-2], tp[:, 1:-1], tp[:, 2:]], axis=2)


def windowed_gqa_with_sink(q, k, v, sink):
    bsz, s = q.shape[0], q.shape[1]
    nb = s // ATTN_BLOCK
    qb = q.astype(jnp.float32).reshape(bsz, nb, ATTN_BLOCK, N_KV_HEADS, Q_PER_KV, HEAD_DIM)
    kb = band_blocks(k.astype(jnp.float32), nb)
    vb = band_blocks(v.astype(jnp.float32), nb)
    scores = jnp.einsum('bnqgrd,bnkgd->bngrqk', qb, kb) * (HEAD_DIM ** -0.5)
    qi = jnp.arange(ATTN_BLOCK)[:, None]
    kj = jnp.arange(3 * ATTN_BLOCK)[None, :]
    band = jnp.abs(kj - ATTN_BLOCK - qi) <= WINDOW
    kpos = jnp.arange(nb)[:, None] * ATTN_BLOCK - ATTN_BLOCK + kj
    kvalid = (kpos >= 0) & (kpos < s)
    mask = band[None] & kvalid[:, None, :]
    scores = jnp.where(mask[None, :, None, None], scores, -jnp.inf)
    sink_l = sink.astype(jnp.float32).reshape(N_KV_HEADS, Q_PER_KV)[None, None, :, :, None, None]
    m = jnp.maximum(jnp.max(scores, axis=-1, keepdims=True), sink_l)
    p = jnp.exp(scores - m)
    denom = jnp.sum(p, axis=-1, keepdims=True) + jnp.exp(sink_l - m)
    out = jnp.einsum('bngrqk,bnkgd->bnqgrd', p / denom, vb)
    return out.reshape(bsz, s, Q_WIDTH).astype(v.dtype)


def spatial_gating(u, sv, ln_g, ln_b, w_s, b_s):
    bsz, s = u.shape[0], u.shape[1]
    nc = s // SGU_CHUNK
    vn = layer_norm(sv, ln_g, ln_b).reshape(bsz, nc, SGU_CHUNK, SGU_GROUPS, SGU_GROUP_DIM)
    z = jnp.einsum('gpq,bcqgd->bcpgd', w_s, vn) + b_s.T[None, None, :, :, None]
    return u * z.reshape(bsz, s, SGU_WIDTH)


def swiglu(h, w_in, w_out):
    gate, up = jnp.split(h @ w_in, 2, axis=-1)
    return (jax.nn.silu(gate) * up) @ w_out


def token_mixer(h, w_mix_in, attn_sink, sgu_ln_g, sgu_ln_b, sgu_w, sgu_b, w_br_attn, w_br_sgu, w_mix_out):
    bsz, s = h.shape[0], h.shape[1]
    z = h @ w_mix_in
    q = rope(z[..., OFF_Q:OFF_K].reshape(bsz, s, N_Q_HEADS, HEAD_DIM))
    k = rope(z[..., OFF_K:OFF_V].reshape(bsz, s, N_KV_HEADS, HEAD_DIM))
    v = z[..., OFF_V:OFF_U].reshape(bsz, s, N_KV_HEADS, HEAD_DIM)
    u = jax.nn.gelu(z[..., OFF_U:OFF_SV])
    sv = jax.nn.gelu(z[..., OFF_SV:OFF_GA])
    attn = windowed_gqa_with_sink(q, k, v, attn_sink) @ w_br_attn
    sgu = spatial_gating(u, sv, sgu_ln_g, sgu_ln_b, sgu_w, sgu_b) @ w_br_sgu
    merged = jax.nn.sigmoid(z[..., OFF_GA:OFF_GB]) * attn + jax.nn.sigmoid(z[..., OFF_GB:]) * sgu
    return merged @ w_mix_out


def encoder_layer(x, c, w_ada, b_ada, ln_g, ln_b, ffn1_w_in, ffn1_w_out, w_mix_in, attn_sink,
                  sgu_ln_g, sgu_ln_b, sgu_w, sgu_b, w_br_attn, w_br_sgu, w_mix_out, ffn2_w_in, ffn2_w_out):
    mod = (jax.nn.silu(c) @ w_ada + b_ada).reshape(c.shape[0], N_MOD, 1, D_MODEL)

    def sublayer(x, i, fn, res_w):
        shift, scale, gate = mod[:, 3 * i], mod[:, 3 * i + 1], mod[:, 3 * i + 2]
        y = fn(x * (1.0 + scale) + shift)
        return layer_norm(DEEPNORM_ALPHA * x + res_w * gate * y, ln_g[i], ln_b[i])

    x = sublayer(x, 0, lambda h: swiglu(h, ffn1_w_in, ffn1_w_out), MACARON_WEIGHT)
    x = sublayer(x, 1, lambda h: token_mixer(h, w_mix_in, attn_sink, sgu_ln_g, sgu_ln_b, sgu_w, sgu_b,
                                             w_br_attn, w_br_sgu, w_mix_out), 1.0)
    x = sublayer(x, 2, lambda h: swiglu(h, ffn2_w_in, ffn2_w_out), MACARON_WEIGHT)
    return x


def setup_inputs(seed: int = 0) -> dict:
    key = jax.random.key(seed)
    ks = jax.random.split(key, 24)
    L, D = DEPTH, D_MODEL

    def nrm(k, shape, scale):
        return jax.random.normal(k, shape, jnp.float32) * scale

    w_mix_in = nrm(ks[8], (L, D, IN_WIDTH), D ** -0.5)
    w_mix_in = w_mix_in.at[:, :, OFF_V:OFF_U].multiply(DEEPNORM_BETA)
    return {
        'x_prompt': nrm(ks[0], (BATCH, SEQ, D), 1.0),
        'x_sample': nrm(ks[1], (DEC_BATCH, DEC_SEQ, D), 1.0),
        'c_prompt': nrm(ks[2], (BATCH, D), 1.0),
        'c_sample': nrm(ks[3], (DEC_BATCH, D), 1.0),
        'w_ada': nrm(ks[4], (L, D, N_MOD * D), D ** -0.5),
        'b_ada': nrm(ks[5], (L, N_MOD * D), 0.02),
        'ln_g': 1.0 + nrm(ks[6], (L, N_SUBLAYERS, D), 0.02),
        'ln_b': nrm(ks[7], (L, N_SUBLAYERS, D), 0.02),
        'ffn1_w_in': nrm(ks[9], (L, D, 2 * D_FF), D ** -0.5),
        'ffn1_w_out': nrm(ks[10], (L, D_FF, D), D_FF ** -0.5 * DEEPNORM_BETA),
        'w_mix_in': w_mix_in,
        'attn_sink': nrm(ks[11], (L, N_Q_HEADS), 0.5),
        'sgu_ln_g': 1.0 + nrm(ks[12], (L, SGU_WIDTH), 0.02),
        'sgu_ln_b': nrm(ks[13], (L, SGU_WIDTH), 0.02),
        'sgu_w': nrm(ks[14], (L, SGU_GROUPS, SGU_CHUNK, SGU_CHUNK), 0.5 * SGU_CHUNK ** -0.5),
        'sgu_b': 1.0 + nrm(ks[15], (L, SGU_GROUPS, SGU_CHUNK), 0.02),
        'w_br_attn': nrm(ks[16], (L, Q_WIDTH, D), Q_WIDTH ** -0.5),
        'w_br_sgu': nrm(ks[17], (L, SGU_WIDTH, D), SGU_WIDTH ** -0.5),
        'w_mix_out': nrm(ks[18], (L, D, D), D ** -0.5 * DEEPNORM_BETA),
        'ffn2_w_in': nrm(ks[19], (L, D, 2 * D_FF), D ** -0.5),
        'ffn2_w_out': nrm(ks[20], (L, D_FF, D), D_FF ** -0.5 * DEEPNORM_BETA),
    }


def reference(x_prompt, x_sample, c_prompt, c_sample, w_ada, b_ada, ln_g, ln_b, ffn1_w_in, ffn1_w_out,
              w_mix_in, attn_sink, sgu_ln_g, sgu_ln_b, sgu_w, sgu_b, w_br_attn, w_br_sgu, w_mix_out,
              ffn2_w_in, ffn2_w_out):
    def run(x, c):
        for l in range(DEPTH):
            x = encoder_layer(x, c, w_ada[l], b_ada[l], ln_g[l], ln_b[l], ffn1_w_in[l], ffn1_w_out[l],
                              w_mix_in[l], attn_sink[l], sgu_ln_g[l], sgu_ln_b[l], sgu_w[l], sgu_b[l],
                              w_br_attn[l], w_br_sgu[l], w_mix_out[l], ffn2_w_in[l], ffn2_w_out[l])
        return x

    y_prompt = run(x_prompt, c_prompt)
    y_sample = run(x_sample, c_sample)
    return (y_prompt, y_sample)
```

```cpp
#include <hip/hip_runtime.h>
#include <cstdio>
#include <cstdint>
#include <cmath>

#ifndef MK_PER_PHASE
#define MK_PER_PHASE 0
#endif
#ifndef PROBE_DUP
#define PROBE_DUP 0
#endif
#define DUP(id) (((PROBE_DUP) >> (id)) & 1)

#define LAS __attribute__((address_space(3)))
#define GAS __attribute__((address_space(1)))
typedef unsigned short bf16_t;
typedef short bf16x8 __attribute__((ext_vector_type(8)));
typedef short s16x4 __attribute__((ext_vector_type(4)));
typedef float f32x4 __attribute__((ext_vector_type(4)));
typedef float f32x2 __attribute__((ext_vector_type(2)));
typedef float f32x16 __attribute__((ext_vector_type(16)));
typedef unsigned u32x4 __attribute__((ext_vector_type(4)));
typedef unsigned u32x2 __attribute__((ext_vector_type(2)));
typedef _Float16 h16x2 __attribute__((ext_vector_type(2)));
typedef GAS bf16_t gbf16;
typedef GAS float gf32;
typedef GAS unsigned char gu8;

constexpr int D = 2048, DEPTH = 2, DFF = 5632, NIN = 11264, NMOD = 9, NB = 6;
constexpr int MP = 8192, MS = 32768, M = MP + MS;
constexpr int NHQ = 16, NHKV = 4, HD = 128, KVW = NHKV * HD;
constexpr int OFF_Q = 0, OFF_K = 2048, OFF_V = 2560, OFF_U = 3072, OFF_SV = 5120, OFF_GA = 7168, OFF_GB = 9216;
constexpr int ZQ = 0, ZU = 2048, ZSV = 4096, ZGA = 6144, ZGB = 8192, ZK = 10240, ZV = 10752;
constexpr size_t ZB_Q = 0, ZB_U = (size_t)M * D, ZB_SV = 2 * (size_t)M * D, ZB_GA = 3 * (size_t)M * D, ZB_GB = 4 * (size_t)M * D, ZB_K = 5 * (size_t)M * D, ZB_V = ZB_K + (size_t)M * KVW;
constexpr float LN_EPS = 1e-5f;
constexpr float DN_ALPHA = 1.4142135623730951f;

constexpr size_t MiB = 1u << 20;
constexpr size_t WS_CTL = 0, CTL_ZERO_BYTES = 1 * MiB;
constexpr size_t WS_MOD = 1 * MiB;
constexpr size_t WS_COS = 2 * MiB, WS_SIN = 4 * MiB;
constexpr size_t WS_SW = 6 * MiB;
constexpr size_t WS_ST = 7 * MiB;
constexpr size_t WS_RS = 7 * MiB + 512 * 1024;
constexpr size_t WS_WT = 8 * MiB;
constexpr size_t WT_FFN1_IN = 0, WT_FFN1_OUT = 44 * MiB, WT_MIX_IN = 66 * MiB, WT_BRA = 110 * MiB, WT_BRS = 118 * MiB, WT_MO = 126 * MiB,
                 WT_FFN2_IN = 134 * MiB, WT_FFN2_OUT = 178 * MiB, WT_END = 200 * MiB;
constexpr size_t WS_H = WS_WT + WT_END;
constexpr size_t WS_Z = WS_H + 160 * MiB;
constexpr size_t WS_Y = WS_Z + 880 * MiB;
constexpr size_t WS_END = WS_Y + 160 * MiB;
static_assert(WT_BRS == WT_BRA + 8 * MiB && ZB_U == ZB_Q + (size_t)M * D && (size_t)M * D * 2 == 160 * MiB && (size_t)M * NIN * 2 == 880 * MiB && (size_t)NIN * D * 2 == 44 * MiB && (size_t)D * DFF * 2 == 22 * MiB && (size_t)M * 8 <= MiB, "ws map");
constexpr int CW_BAR = 4096;

constexpr int LDS_BYTES = 147456;
constexpr int MISC_OFF = 131072 + 8192;

__device__ __forceinline__ unsigned cvt_pk_bf16(float lo, float hi) { unsigned r; asm volatile("v_cvt_pk_bf16_f32 %0, %1, %2" : "=v"(r) : "v"(lo), "v"(hi)); return r; }
__device__ __forceinline__ unsigned pk_f16(float lo, float hi) { const h16x2 h = {(_Float16)lo, (_Float16)hi}; return __builtin_bit_cast(unsigned, h); }
__device__ __forceinline__ float f16lo(unsigned w) { return (float)__builtin_bit_cast(h16x2, w)[0]; }
__device__ __forceinline__ float f16hi(unsigned w) { return (float)__builtin_bit_cast(h16x2, w)[1]; }
__device__ __forceinline__ float bflo(unsigned w) { return __uint_as_float(w << 16); }
__device__ __forceinline__ float bfhi(unsigned w) { return __uint_as_float(w & 0xffff0000u); }
template <int XM> __device__ __forceinline__ float swz_xor(float v) { return __int_as_float(__builtin_amdgcn_ds_swizzle(__float_as_int(v), (XM << 10) | 0x1F)); }
__device__ __forceinline__ float wave_sum(float v) {
    v += swz_xor<1>(v); v += swz_xor<2>(v); v += swz_xor<4>(v); v += swz_xor<8>(v); v += swz_xor<16>(v);
    auto rr = __builtin_amdgcn_permlane32_swap(__float_as_uint(v), __float_as_uint(v), false, false);
    return __uint_as_float(rr[0]) + __uint_as_float(rr[1]);
}
__device__ __forceinline__ int wg_wave_index() { return __builtin_amdgcn_readfirstlane((int)(threadIdx.x >> 6)); }
__device__ __forceinline__ int make_tid(int wave_s) { int l; asm volatile("v_mbcnt_lo_u32_b32 %0, -1, 0\n\tv_mbcnt_hi_u32_b32 %0, -1, %0" : "=v"(l)); return wave_s * 64 + l; }
__device__ __forceinline__ float fast_exp2(float x) { return __builtin_amdgcn_exp2f(x); }
__device__ __forceinline__ float fast_rcp(float x) { return __builtin_amdgcn_rcpf(x); }
__device__ __forceinline__ float silu_f(float x) { return x * fast_rcp(1.0f + fast_exp2(-1.4426950408889634f * x)); }
__device__ __forceinline__ float sigmoid_f(float x) { return fast_rcp(1.0f + fast_exp2(-1.4426950408889634f * x)); }
__device__ __forceinline__ float gelu_tanh_f(float x) {
    const float x2 = x * x, p = fmaf(x2, -2.0f * 1.4426950408889634f * 0.7978845608028654f * 0.044715f, -2.0f * 1.4426950408889634f * 0.7978845608028654f);
    return x * fast_rcp(1.0f + fast_exp2(x * p));
}
__device__ __forceinline__ int batch_of(int row) { return row < MP ? (row >> 12) : 2 + ((row - MP) >> 13); }
__device__ __forceinline__ int pos_of(int row) { return row < MP ? (row & 4095) : (row & 8191); }
__host__ __device__ __forceinline__ int dperm(int p) { return 16 * (p >> 5) + 4 * ((p >> 3) & 3) + (p & 3) + 64 * ((p >> 2) & 1); }

namespace pg8 {
constexpr int BM = 256, BK = 64, HALF = 128, HTB = HALF * BK * 2, STAGE_BYTES = 8 * HTB, NXCD = 8, WGM = 8;
__host__ __device__ __forceinline__ int lds_byte(int r, int c) { const int st = (r >> 4) * 2 + (c >> 5), rr = r & 15, cc = c & 31, ob = rr * 64 + cc * 2; return st * 1024 + (ob ^ (((ob >> 9) & 1) << 5)); }
__host__ __device__ __forceinline__ void stage_rc(int b, int& R, int& C) { const int st = b / 1024, sb = b % 1024, swz = sb ^ (((sb >> 9) & 1) << 5); R = (st >> 1) * 16 + swz / 64; C = (st & 1) * 32 + (swz % 64) / 2; }
__host__ __device__ __forceinline__ int perm32(int rho) { const int n = rho >> 4, i = rho & 15; return 8 * (i >> 2) + 4 * n + (i & 3); }
struct Unit { int pm, pn; };
struct Gemm { const gbf16* A; const gbf16* Bt; };
template <int N_> struct StaticOrder {
    static constexpr int nM = M / BM, nN = N_ / BM, nwg = nM * nN;
    static constexpr int WG = (nN == 8) ? 4 : WGM;
    int G, c, rev;
    __host__ __device__ void init(int G_, int c_, int rev_ = 0) { G = G_; c = c_; rev = rev_; }
    __host__ __device__ bool next(int i, Unit& u) const {
        const long L = (long)i * G + c; if (L >= nwg) return false;
        int wgid = (int)L; { const int q = nwg / NXCD, r = nwg % NXCD, xcd = wgid % NXCD, off = wgid / NXCD; wgid = (xcd < r ? xcd * (q + 1) : r * (q + 1) + (xcd - r) * q) + off; }
        const int nig = WG * nN, gid = wgid / nig, fm = gid * WG, gsz = (nM - fm) < WG ? (nM - fm) : WG;
        u.pm = fm + ((wgid % nig) % gsz); u.pn = (wgid % nig) / gsz; if (rev) u.pm = nM - 1 - u.pm; return true;
    }
};

template <class Epi, int N, int K, int lda, bool ALIGN_EPI, bool SP2, int ldb = K, int KSA = BK * 2, int KSB = BK * 2, int TJ = 0, size_t JUMPA = 0>
__device__ __forceinline__ void gemm_phase(LAS unsigned char* lds, const Gemm g, const StaticOrder<N>& S, const Epi& E, int wave_s) {
    const int tid = make_tid(wave_s), wid = __builtin_amdgcn_readfirstlane(tid >> 6), lane = tid & 63, wr = wid >> 2, wc = wid & 3, fr = lane & 15, fq = lane >> 4;
    constexpr int nt = K / BK;
    unsigned voffA[2], voffB[2];
#pragma unroll
    for (int i = 0; i < 2; ++i) { int R, C; stage_rc(tid * 16 + i * 8192, R, C); const int Rb = Epi::PERM ? ((R & ~31) + perm32(R & 31)) : R;
        voffA[i] = (unsigned)(R * lda + C) * 2u; voffB[i] = (unsigned)(Rb * ldb + C) * 2u; }
    constexpr size_t kstepA = (size_t)KSA, kstepB = (size_t)KSB;
    constexpr size_t hstepA = (size_t)HALF * lda * 2, hstepB = (size_t)HALF * ldb * 2;
    constexpr size_t tstepA = (KSA == BK * 2) ? 2 * hstepA : (size_t)(K / BK) * KSA, tstepB = (KSB == BK * 2) ? 2 * hstepB : (size_t)(K / BK) * KSB;
    const unsigned ldsw = (unsigned)wid * 1024u;
    const int aoff = lds_byte(wr * 64 + fr, fq * 8), boff = lds_byte(wc * 32 + fr, fq * 8);
#define PG8_SA(b, h) (((b) * 2 + (h)) * HTB)
#define PG8_SB(b, h) ((4 + (b) * 2 + (h)) * HTB)
#define PG8_STAGE(bufoff, gbase, voff) do { _Pragma("unroll") for (int _i = 0; _i < 2; ++_i) \
        __builtin_amdgcn_global_load_lds((const GAS unsigned*)((const GAS char*)(gbase) + (voff)[_i]), (LAS unsigned*)(lds + (bufoff) + ldsw + _i * 8192), 16, 0, 0); } while (0)
#define PG8_LDA(dst, b, h) do { _Pragma("unroll") for (int m = 0; m < 4; ++m) _Pragma("unroll") for (int k = 0; k < 2; ++k) dst[m][k] = *(const LAS bf16x8*)(lds + PG8_SA(b, h) + aoff + m * 2048 + k * 1024); } while (0)
#define PG8_LDB(dst, b, h) do { _Pragma("unroll") for (int n = 0; n < 2; ++n) _Pragma("unroll") for (int k = 0; k < 2; ++k) dst[n][k] = *(const LAS bf16x8*)(lds + PG8_SB(b, h) + boff + n * 2048 + k * 1024); } while (0)
#define PG8_MMA(ai, bj, At, Bt) do { __builtin_amdgcn_s_setprio(1); _Pragma("unroll") for (int m = 0; m < 4; ++m) _Pragma("unroll") for (int n = 0; n < 2; ++n) _Pragma("unroll") for (int k = 0; k < 2; ++k) \
        acc[ai][bj][m][n] = __builtin_amdgcn_mfma_f32_16x16x32_bf16(Bt[n][k], At[m][k], acc[ai][bj][m][n], 0, 0, 0); __builtin_amdgcn_s_setprio(0); } while (0)
#define PG8_WAIT_V(n) asm volatile("s_waitcnt vmcnt(" #n ")" ::: "memory")
#define PG8_WAIT_L(n) asm volatile("s_waitcnt lgkmcnt(" #n ")" ::: "memory")
#define PG8_BAR __builtin_amdgcn_s_barrier()
#define PG8_SCHED __builtin_amdgcn_sched_barrier(0)
    Unit cur, nxt; int ui = 0;
    if (!S.next(0, cur)) return;
    f32x4 acc[2][2][4][2];
#pragma unroll
    for (int a = 0; a < 2; ++a)
#pragma unroll
        for (int b = 0; b < 2; ++b)
#pragma unroll
            for (int m = 0; m < 4; ++m)
#pragma unroll
                for (int n = 0; n < 2; ++n) acc[a][b][m][n] = (f32x4){0.f, 0.f, 0.f, 0.f};
    bf16x8 At[4][2], B0[2][2], B1[2][2];
    const GAS char* cA = (const GAS char*)g.A + (size_t)cur.pm * tstepA; const GAS char* cB = (const GAS char*)g.Bt + (size_t)cur.pn * tstepB;
    if constexpr (SP2) {
        PG8_STAGE(PG8_SB(0, 0), cB, voffB); PG8_STAGE(PG8_SB(0, 1), cB + hstepB, voffB); PG8_STAGE(PG8_SA(0, 0), cA, voffA); PG8_STAGE(PG8_SA(0, 1), cA + hstepA, voffA);
        if (wr == 1) PG8_BAR;
        PG8_WAIT_V(2); PG8_BAR;
        PG8_STAGE(PG8_SB(1, 0), cB + kstepB, voffB); PG8_STAGE(PG8_SA(1, 0), cA + kstepA, voffA); PG8_STAGE(PG8_SB(1, 1), cB + hstepB + kstepB, voffB);
        PG8_WAIT_V(6); PG8_BAR;
    } else {
        PG8_STAGE(PG8_SB(0, 0), cB, voffB); PG8_STAGE(PG8_SA(0, 0), cA, voffA); PG8_STAGE(PG8_SB(0, 1), cB + hstepB, voffB); PG8_STAGE(PG8_SA(0, 1), cA + hstepA, voffA);
        if (wr == 1) PG8_BAR;
        PG8_WAIT_V(4); PG8_BAR;
        PG8_STAGE(PG8_SB(1, 0), cB + kstepB, voffB); PG8_STAGE(PG8_SA(1, 0), cA + kstepA, voffA); PG8_STAGE(PG8_SB(1, 1), cB + hstepB + kstepB, voffB);
        PG8_WAIT_V(6); PG8_BAR;
    }
    for (;;) {
        const bool has_next = S.next(ui + 1, nxt);
        const GAS char* nA = has_next ? (const GAS char*)g.A + (size_t)nxt.pm * tstepA : cA; const GAS char* nB = has_next ? (const GAS char*)g.Bt + (size_t)nxt.pn * tstepB : cB;
        for (int t = 0; t < nt; t += 2) {
            const bool last = (t == nt - 2);
            const size_t j1 = (TJ > 0 && t >= TJ) ? JUMPA : 0, j2 = (TJ > 0 && t + 2 >= TJ) ? JUMPA : 0;
            const GAS char* a1 = cA + (size_t)(t + 1) * kstepA + j1;
            const GAS char* a2 = last ? nA : cA + (size_t)(t + 2) * kstepA + j2; const GAS char* b2 = last ? nB : cB + (size_t)(t + 2) * kstepB;
            const GAS char* a3 = a2 + kstepA; const GAS char* b3 = b2 + kstepB;
            asm volatile("" : "+s"(a1), "+s"(a2), "+s"(b2), "+s"(a3), "+s"(b3), "+v"(voffA[0]), "+v"(voffA[1]), "+v"(voffB[0]), "+v"(voffB[1]));
            if constexpr (TJ > 0) { if (t == TJ) E.mid(acc, cur, wr, wc, fr, fq); }
            if constexpr (SP2) {
            PG8_LDB(B0, 0, 0); PG8_LDB(B1, 0, 1); PG8_SCHED; PG8_LDA(At, 0, 0); PG8_STAGE(PG8_SA(1, 1), a1 + hstepA, voffA);
            PG8_WAIT_V(8); PG8_WAIT_L(0); PG8_BAR; PG8_MMA(0, 0, At, B0); PG8_MMA(0, 1, At, B1); PG8_BAR; PG8_SCHED;
            PG8_LDA(At, 0, 1); PG8_STAGE(PG8_SB(0, 0), b2, voffB); PG8_STAGE(PG8_SB(0, 1), b2 + hstepB, voffB); PG8_STAGE(PG8_SA(0, 0), a2, voffA);
            PG8_WAIT_V(8); PG8_WAIT_L(0); PG8_BAR; PG8_MMA(1, 0, At, B0); PG8_MMA(1, 1, At, B1); PG8_BAR; PG8_SCHED;
            PG8_LDB(B0, 1, 0); PG8_LDB(B1, 1, 1); PG8_SCHED; PG8_LDA(At, 1, 0); PG8_STAGE(PG8_SA(0, 1), a2 + hstepA, voffA);
            PG8_WAIT_V(8); PG8_WAIT_L(0); PG8_BAR; PG8_MMA(0, 0, At, B0); PG8_MMA(0, 1, At, B1); PG8_BAR; PG8_SCHED;
            PG8_LDA(At, 1, 1); PG8_STAGE(PG8_SB(1, 0), b3, voffB); PG8_STAGE(PG8_SB(1, 1), b3 + hstepB, voffB); PG8_STAGE(PG8_SA(1, 0), a3, voffA);
            PG8_WAIT_V(8); PG8_WAIT_L(0); PG8_BAR; PG8_MMA(1, 0, At, B0); PG8_MMA(1, 1, At, B1); PG8_BAR; PG8_SCHED;
            } else {
            PG8_LDB(B0, 0, 0); PG8_SCHED; PG8_LDA(At, 0, 0); PG8_STAGE(PG8_SA(1, 1), a1 + hstepA, voffA);
            PG8_WAIT_L(8); PG8_BAR; PG8_WAIT_L(0); PG8_MMA(0, 0, At, B0); PG8_BAR; PG8_SCHED;
            PG8_LDB(B1, 0, 1); PG8_STAGE(PG8_SB(0, 0), b2, voffB);
            PG8_BAR; PG8_WAIT_L(0); PG8_MMA(0, 1, At, B1); PG8_BAR;
            PG8_LDA(At, 0, 1); PG8_STAGE(PG8_SA(0, 0), a2, voffA);
            PG8_BAR; PG8_WAIT_L(0); PG8_MMA(1, 0, At, B0); PG8_BAR; PG8_SCHED;
            PG8_STAGE(PG8_SB(0, 1), b2 + hstepB, voffB);
            PG8_WAIT_V(6); PG8_BAR; PG8_MMA(1, 1, At, B1); PG8_BAR;
            PG8_LDB(B0, 1, 0); PG8_SCHED; PG8_LDA(At, 1, 0); PG8_STAGE(PG8_SA(0, 1), a2 + hstepA, voffA);
            PG8_WAIT_L(8); PG8_BAR; PG8_WAIT_L(0); PG8_MMA(0, 0, At, B0); PG8_BAR; PG8_SCHED;
            PG8_LDB(B1, 1, 1); PG8_STAGE(PG8_SB(1, 0), b3, voffB);
            PG8_BAR; PG8_WAIT_L(0); PG8_MMA(0, 1, At, B1); PG8_BAR;
            PG8_LDA(At, 1, 1); PG8_STAGE(PG8_SA(1, 0), a3, voffA);
            PG8_BAR; PG8_WAIT_L(0); PG8_MMA(1, 0, At, B0); PG8_BAR; PG8_SCHED;
            PG8_STAGE(PG8_SB(1, 1), b3 + hstepB, voffB);
            PG8_WAIT_V(6); PG8_BAR; PG8_MMA(1, 1, At, B1); PG8_BAR;
            }
        }
        if constexpr (ALIGN_EPI) { if (wr == 0) PG8_BAR; }
        E(acc, cur, wr, wc, fr, fq);
        if (!has_next) break;
#pragma unroll
        for (int a = 0; a < 2; ++a)
#pragma unroll
            for (int b = 0; b < 2; ++b)
#pragma unroll
                for (int m = 0; m < 4; ++m)
#pragma unroll
                    for (int n = 0; n < 2; ++n) acc[a][b][m][n] = (f32x4){0.f, 0.f, 0.f, 0.f};
        cur = nxt; cA = nA; cB = nB; ++ui;
        if constexpr (ALIGN_EPI) { if (wr == 1) PG8_BAR; }
    }
    PG8_WAIT_V(0);
    if constexpr (!ALIGN_EPI) { if (wr == 0) PG8_BAR; }
    PG8_BAR;
#undef PG8_SA
#undef PG8_SB
#undef PG8_STAGE
#undef PG8_LDA
#undef PG8_LDB
#undef PG8_MMA
#undef PG8_WAIT_V
#undef PG8_WAIT_L
#undef PG8_BAR
#undef PG8_SCHED
}

struct EpiNone {
    static constexpr bool PERM = true;
    __device__ __forceinline__ void operator()(const f32x4 (&acc)[2][2][4][2], const Unit&, int, int, int, int) const {
#pragma unroll
        for (int a = 0; a < 2; ++a)
#pragma unroll
            for (int b = 0; b < 2; ++b)
#pragma unroll
                for (int m = 0; m < 4; ++m)
#pragma unroll
                    for (int n = 0; n < 2; ++n) asm volatile("" :: "v"(acc[a][b][m][n]));
    }
};
struct EpiSwiglu {
    static constexpr bool PERM = true;
    gbf16* O;
    __device__ __forceinline__ void operator()(const f32x4 (&acc)[2][2][4][2], const Unit& u, int wr, int wc, int fr, int fq) const {
        const int row0 = u.pm * BM + wr * 64 + fr, col0 = u.pn * HALF + wc * 32 + 8 * fq;
#pragma unroll
        for (int ai = 0; ai < 2; ++ai)
#pragma unroll
            for (int m = 0; m < 4; ++m) {
                gbf16* rowp = O + (size_t)(row0 + ai * HALF + m * 16) * DFF + col0;
                const f32x4 g0 = acc[ai][0][m][0], g1 = acc[ai][0][m][1], u0 = acc[ai][1][m][0], u1 = acc[ai][1][m][1];
                u32x4 w;
                w.x = cvt_pk_bf16(silu_f(g0[0]) * u0[0], silu_f(g0[1]) * u0[1]); w.y = cvt_pk_bf16(silu_f(g0[2]) * u0[2], silu_f(g0[3]) * u0[3]);
                w.z = cvt_pk_bf16(silu_f(g1[0]) * u1[0], silu_f(g1[1]) * u1[1]); w.w = cvt_pk_bf16(silu_f(g1[2]) * u1[2], silu_f(g1[3]) * u1[3]);
                *(GAS u32x4*)rowp = w;
            }
    }
};
template <int LNF> struct EpiResid {
    static constexpr bool PERM = true; static constexpr int ln = LNF;
    const gf32* xsrc_p; const gf32* xsrc_s;
    GAS unsigned short* Y;
    const gf32* gate;
    const gf32* rs; const gf32* lng; const gf32* lnb;
    float wgt;
    __device__ __forceinline__ void operator()(const f32x4 (&acc)[2][2][4][2], const Unit& u, int wr, int wc, int fr, int fq) const {
        const int rowt = u.pm * BM, row0 = rowt + wr * 64 + fr, col0 = u.pn * BM + wc * 32 + 8 * fq;
        const int b = batch_of(rowt);
        const gf32* gp = gate + (size_t)b * NMOD * D + col0;
#pragma unroll
        for (int ai = 0; ai < 2; ++ai) {
            f32x2 st[4];
#pragma unroll
            for (int m = 0; m < 4; ++m) { st[m] = (f32x2){0.f, 1.f}; if (ln) st[m] = *(const GAS f32x2*)(rs + 2 * (size_t)(row0 + ai * HALF + m * 16)); }
#pragma unroll
            for (int bj = 0; bj < 2; ++bj) {
                const int co = bj * HALF;
                u32x4 yw[4]; u32x2 pk[4];
                if (ln) {
#pragma unroll
                    for (int m = 0; m < 4; ++m) yw[m] = *(const GAS u32x4*)(Y + (size_t)(row0 + ai * HALF + m * 16) * D + col0 + co);
                }
#pragma unroll
                for (int n = 0; n < 2; ++n) {
                    const f32x4 gv = *(const GAS f32x4*)(gp + co + 4 * n) * wgt;
                    f32x4 ga = (f32x4){DN_ALPHA, DN_ALPHA, DN_ALPHA, DN_ALPHA}, ba = (f32x4){0.f, 0.f, 0.f, 0.f};
                    if (ln) { ga = *(const GAS f32x4*)(lng + col0 + co + 4 * n) * DN_ALPHA; ba = *(const GAS f32x4*)(lnb + col0 + co + 4 * n) * DN_ALPHA; }
                    f32x4 xv[4];
                    if (ln) {
#pragma unroll
                        for (int m = 0; m < 4; ++m) { const unsigned w0 = n ? yw[m].z : yw[m].x, w1 = n ? yw[m].w : yw[m].y; xv[m] = (f32x4){f16lo(w0), f16hi(w0), f16lo(w1), f16hi(w1)}; }
                    } else {
                        const gf32* xs = (rowt < MP) ? xsrc_p + (size_t)row0 * D : xsrc_s + (size_t)(row0 - MP) * D;
#pragma unroll
                        for (int m = 0; m < 4; ++m) xv[m] = *(const GAS f32x4*)(xs + (size_t)(ai * HALF + m * 16) * D + col0 + co + 4 * n);
                    }
#pragma unroll
                    for (int m = 0; m < 4; ++m) {
                        const f32x4 o = (xv[m] - st[m].x) * st[m].y * ga + ba + gv * acc[ai][bj][m][n];
                        const u32x2 p2 = {pk_f16(o[0], o[1]), pk_f16(o[2], o[3])};
                        if (n == 0) pk[m] = p2;
                        else *(GAS u32x4*)(Y + (size_t)(row0 + ai * HALF + m * 16) * D + col0 + co) = (u32x4){pk[m].x, pk[m].y, p2.x, p2.y};
                    }
                }
            }
        }
    }
};
struct EpiMix {
    static constexpr bool PERM = true;
    gbf16* Z; const gf32* cosT; const gf32* sinT; gf32* SP;
    __device__ __forceinline__ void operator()(const f32x4 (&acc)[2][2][4][2], const Unit& u, int wr, int wc, int fr, int fq) const {
        const int pn = u.pn, row0 = u.pm * BM + wr * 64 + fr;
        const int reg = pn < 40 ? (pn >> 3) : 5 + ((pn - 40) >> 1);
        const int ld = pn < 40 ? D : KVW;
        const int colt = pn < 40 ? (pn & 7) * BM : ((pn - 40) & 1) * BM;
        const size_t roff = pn < 40 ? (size_t)reg * ((size_t)M * D) : ZB_K + (size_t)(reg - 5) * ((size_t)M * KVW);
        gbf16* base = Z + roff + colt + wc * 32 + 8 * fq;
        const int kind = (reg == 0 || reg == 5) ? 0 : (reg <= 2 ? 1 : (reg <= 4 ? 2 : 3));
        if (kind == 0) {
#pragma unroll
            for (int ai = 0; ai < 2; ++ai) {
                f32x4 c4[4], s4[4];
#pragma unroll
                for (int m = 0; m < 4; ++m) { const int pos = pos_of(row0 + ai * HALF + m * 16);
                    c4[m] = *(const GAS f32x4*)(cosT + (size_t)pos * 64 + wc * 16 + fq * 4); s4[m] = *(const GAS f32x4*)(sinT + (size_t)pos * 64 + wc * 16 + fq * 4); }
#pragma unroll
                for (int m = 0; m < 4; ++m) { gbf16* rowp = base + (size_t)(row0 + ai * HALF + m * 16) * ld;
#pragma unroll
                    for (int bj = 0; bj < 2; ++bj) { const f32x4 x1 = acc[ai][bj][m][0], x2 = acc[ai][bj][m][1];
                        const f32x4 o1 = x1 * c4[m] - x2 * s4[m], o2 = x2 * c4[m] + x1 * s4[m];
                        u32x4 w; w.x = cvt_pk_bf16(o1[0], o1[1]); w.y = cvt_pk_bf16(o1[2], o1[3]); w.z = cvt_pk_bf16(o2[0], o2[1]); w.w = cvt_pk_bf16(o2[2], o2[3]);
                        *(GAS u32x4*)(rowp + bj * HALF) = w; } }
            }
        } else {
#pragma unroll
            for (int ai = 0; ai < 2; ++ai)
#pragma unroll
                for (int m = 0; m < 4; ++m) { gbf16* rowp = base + (size_t)(row0 + ai * HALF + m * 16) * ld;
                    float rs_ = 0.f, rq_ = 0.f;
#pragma unroll
                    for (int bj = 0; bj < 2; ++bj) { f32x4 v0 = acc[ai][bj][m][0], v1 = acc[ai][bj][m][1];
                        if (kind == 1) {
#pragma unroll
                            for (int j = 0; j < 4; ++j) { v0[j] = gelu_tanh_f(v0[j]); v1[j] = gelu_tanh_f(v1[j]); }
                            if (reg == 2) {
#pragma unroll
                                for (int j = 0; j < 4; ++j) { rs_ += v0[j] + v1[j]; rq_ += v0[j] * v0[j] + v1[j] * v1[j]; } }
                        } else if (kind == 2) {
#pragma unroll
                            for (int j = 0; j < 4; ++j) { v0[j] = sigmoid_f(v0[j]); v1[j] = sigmoid_f(v1[j]); }
                        }
                        u32x4 w; w.x = cvt_pk_bf16(v0[0], v0[1]); w.y = cvt_pk_bf16(v0[2], v0[3]); w.z = cvt_pk_bf16(v1[0], v1[1]); w.w = cvt_pk_bf16(v1[2], v1[3]);
                        *(GAS u32x4*)(rowp + bj * HALF) = w; }
                    if (reg == 2) {
                        rs_ += swz_xor<16>(rs_); rq_ += swz_xor<16>(rq_);
                        { auto r1 = __builtin_amdgcn_permlane32_swap(__float_as_uint(rs_), __float_as_uint(rs_), false, false); rs_ = __uint_as_float(r1[0]) + __uint_as_float(r1[1]);
                          auto r2 = __builtin_amdgcn_permlane32_swap(__float_as_uint(rq_), __float_as_uint(rq_), false, false); rq_ = __uint_as_float(r2[0]) + __uint_as_float(r2[1]); }
                        if (fq == 0) *(GAS f32x2*)(SP + ((size_t)(row0 + ai * HALF + m * 16) * 32 + (pn - 16) * 4 + wc) * 2) = (f32x2){rs_, rq_}; } }
        }
    }
};
struct EpiBranchF {
    static constexpr bool PERM = true;
    gbf16* O; const gbf16* Ga; const gbf16* Gb;
    __device__ __forceinline__ void mid(f32x4 (&acc)[2][2][4][2], const Unit& u, int wr, int wc, int fr, int fq) const {
        const gbf16* Ga = this->Ga; const gbf16* Gb = this->Gb; int rowl = wr * 64 + fr;
        asm volatile("" : "+s"(Ga), "+s"(Gb), "+v"(rowl));
        const int row0 = u.pm * BM + rowl, col0 = u.pn * BM + wc * 32 + 8 * fq;
#pragma unroll
        for (int ai = 0; ai < 2; ++ai)
#pragma unroll
            for (int mp = 0; mp < 2; ++mp) {
                u32x4 ga[2][2], gb[2][2];
#pragma unroll
                for (int mm = 0; mm < 2; ++mm)
#pragma unroll
                    for (int bj = 0; bj < 2; ++bj) { const size_t o = (size_t)(row0 + ai * HALF + (2 * mp + mm) * 16) * D + col0 + bj * HALF; ga[mm][bj] = *(const GAS u32x4*)(Ga + o); gb[mm][bj] = *(const GAS u32x4*)(Gb + o); }
#pragma unroll
                for (int mm = 0; mm < 2; ++mm)
#pragma unroll
                    for (int bj = 0; bj < 2; ++bj) { const u32x4 a4 = ga[mm][bj], b4 = gb[mm][bj]; const int m = 2 * mp + mm;
                        const float sa[8] = { bflo(a4.x), bfhi(a4.x), bflo(a4.y), bfhi(a4.y), bflo(a4.z), bfhi(a4.z), bflo(a4.w), bfhi(a4.w) };
                        const float sb[8] = { bflo(b4.x), bfhi(b4.x), bflo(b4.y), bfhi(b4.y), bflo(b4.z), bfhi(b4.z), bflo(b4.w), bfhi(b4.w) };
#pragma unroll
                        for (int j = 0; j < 4; ++j) { acc[ai][bj][m][0][j] *= sa[j] * fast_rcp(fmaxf(sb[j], 8.673617379884035e-19f)); acc[ai][bj][m][1][j] *= sa[4 + j] * fast_rcp(fmaxf(sb[4 + j], 8.673617379884035e-19f)); } }
            }
    }
    __device__ __forceinline__ void operator()(const f32x4 (&acc)[2][2][4][2], const Unit& u, int wr, int wc, int fr, int fq) const {
        const int row0 = u.pm * BM + wr * 64 + fr, col0 = u.pn * BM + wc * 32 + 8 * fq;
#pragma unroll
        for (int ai = 0; ai < 2; ++ai) {
            u32x4 gb[4][2];
#pragma unroll
            for (int m = 0; m < 4; ++m)
#pragma unroll
                for (int bj = 0; bj < 2; ++bj) gb[m][bj] = *(const GAS u32x4*)(Gb + (size_t)(row0 + ai * HALF + m * 16) * D + col0 + bj * HALF);
#pragma unroll
            for (int m = 0; m < 4; ++m)
#pragma unroll
                for (int bj = 0; bj < 2; ++bj) { const u32x4 b4 = gb[m][bj]; const f32x4 v0 = acc[ai][bj][m][0], v1 = acc[ai][bj][m][1];
                    const float sb[8] = { bflo(b4.x), bfhi(b4.x), bflo(b4.y), bfhi(b4.y), bflo(b4.z), bfhi(b4.z), bflo(b4.w), bfhi(b4.w) };
                    float r[8];
#pragma unroll
                    for (int j = 0; j < 4; ++j) { r[j] = v0[j] * fmaxf(sb[j], 8.673617379884035e-19f); r[4 + j] = v1[j] * fmaxf(sb[4 + j], 8.673617379884035e-19f); }
                    u32x4 w; w.x = cvt_pk_bf16(r[0], r[1]); w.y = cvt_pk_bf16(r[2], r[3]); w.z = cvt_pk_bf16(r[4], r[5]); w.w = cvt_pk_bf16(r[6], r[7]);
                    *(GAS u32x4*)(O + (size_t)(row0 + ai * HALF + m * 16) * D + col0 + bj * HALF) = w; }
        }
    }
};
}

namespace att {
constexpr int KVBLK = 64, NW = 8, QBLK = 32;
constexpr float SCALE = 0.088388347648318440f;
constexpr float THR = 8.f;
#ifndef ATT_SDEPTH
#define ATT_SDEPTH 1
#endif
constexpr int SDEPTH = ATT_SDEPTH;
constexpr int SHM_V = KVBLK * HD * 2, SHM_K = KVBLK * HD * 2;
#define KSWZ(row, colB) ((row) * 256 + ((colB) ^ (((row) & 7) << 4)))
#define SBAR() __builtin_amdgcn_sched_barrier(0)
__device__ __forceinline__ int crow(int r, int hi) { return (r & 3) + 8 * (r >> 2) + 4 * hi; }
__device__ __forceinline__ void partialSM(f32x16& p0, f32x16& p1, float& m_reg, float& mn, float& alpha) {
  constexpr float C = SCALE * 1.4426950408889634f;
  float pmax = p0[0];
#pragma unroll
  for (int r = 1; r < 16; ++r) pmax = fmaxf(pmax, p0[r]);
#pragma unroll
  for (int r = 0; r < 16; ++r) pmax = fmaxf(pmax, p1[r]);
  { auto rr = __builtin_amdgcn_permlane32_swap(__float_as_uint(pmax), __float_as_uint(pmax), false, false);
    pmax = fmaxf(__uint_as_float(rr[0]), __uint_as_float(rr[1])); }
  if (__builtin_expect(__all(pmax - m_reg <= THR / SCALE), 1)) { mn = m_reg; alpha = 1.f; }
  else { mn = fmaxf(m_reg, pmax); alpha = __builtin_amdgcn_exp2f((m_reg - mn) * C); m_reg = mn; }
  float mnC = -mn * C;
#pragma unroll
  for (int r = 0; r < 16; ++r) p0[r] = fmaf(p0[r], C, mnC);
#pragma unroll
  for (int r = 0; r < 16; ++r) p1[r] = fmaf(p1[r], C, mnC);
#pragma unroll
  for (int r = 0; r < 16; ++r) p0[r] = __builtin_amdgcn_exp2f(p0[r]);
}
__device__ __forceinline__ void finishSM(f32x16& p0, f32x16& p1, float alpha, float& l_reg, bf16x8& pa0, bf16x8& pa1, bf16x8& pa2, bf16x8& pa3) {
#pragma unroll
  for (int r = 0; r < 16; ++r) p1[r] = __builtin_amdgcn_exp2f(p1[r]);
  float ps = 0;
#pragma unroll
  for (int r = 0; r < 16; ++r) ps += p0[r];
#pragma unroll
  for (int r = 0; r < 16; ++r) ps += p1[r];
  { auto rr = __builtin_amdgcn_permlane32_swap(__float_as_uint(ps), __float_as_uint(ps), false, false);
    ps = __uint_as_float(rr[0]) + __uint_as_float(rr[1]); }
  l_reg = l_reg * alpha + ps;
#define PK4(P, BASE, OUT) do { unsigned a0 = cvt_pk_bf16(P[BASE + 0], P[BASE + 1]), a1 = cvt_pk_bf16(P[BASE + 2], P[BASE + 3]);   \
    unsigned b0 = cvt_pk_bf16(P[BASE + 4], P[BASE + 5]), b1 = cvt_pk_bf16(P[BASE + 6], P[BASE + 7]);                              \
    auto r0 = __builtin_amdgcn_permlane32_swap(a0, b0, false, false); auto r1 = __builtin_amdgcn_permlane32_swap(a1, b1, false, false); \
    u32x4 w = {r0[0], r1[0], r0[1], r1[1]}; OUT = *reinterpret_cast<bf16x8*>(&w); } while (0)
  PK4(p0, 0, pa0); PK4(p0, 8, pa1); PK4(p1, 0, pa2); PK4(p1, 8, pa3);
#undef PK4
}
__device__ __forceinline__ void qkt(f32x16& p0, f32x16& p1, const LAS char* Ks, const bf16x8* qr, int r32, int hi) {
  p0 = f32x16{}; p1 = f32x16{};
#pragma unroll
  for (int d0 = 0; d0 < 8; ++d0) { int cb = (d0 * 16 + hi * 8) * 2;
    bf16x8 b0 = *(const LAS bf16x8*)(Ks + KSWZ(r32, cb));
    bf16x8 b1 = *(const LAS bf16x8*)(Ks + KSWZ(32 + r32, cb));
    p0 = __builtin_amdgcn_mfma_f32_32x32x16_bf16(b0, qr[d0], p0, 0, 0, 0);
    p1 = __builtin_amdgcn_mfma_f32_32x32x16_bf16(b1, qr[d0], p1, 0, 0, 0); }
}
__device__ __forceinline__ void band_mask(f32x16& p0, f32x16& p1, int ktp, int q, int hi) {
  const float ninf = -__builtin_inff();
  if (ktp < 2) { const int kb = 64 * ktp - 128, lim = q - 128;
#pragma unroll
    for (int r = 0; r < 16; ++r) { const int k = kb + crow(r, hi); if (k < lim) p0[r] = ninf; if (k + 32 < lim) p1[r] = ninf; }
  } else if (ktp >= 4) { const int kb = 64 * ktp - 128, lim = q + 128;
#pragma unroll
    for (int r = 0; r < 16; ++r) { const int k = kb + crow(r, hi); if (k > lim) p0[r] = ninf; if (k + 32 > lim) p1[r] = ninf; }
  }
}
__device__ __forceinline__ int v_st(int k, int c) { const int kk = (k & ~0xC) | ((k & 4) << 1) | ((k & 8) >> 1); return ((kk >> 3) * 4 + (c >> 5)) * 512 + ((kk & 7) * 32 + (c & 31)) * 2; }
__device__ __forceinline__ int v_rd_base(int lane) { return ((lane & 3) << 3) | (((lane >> 2) & 3) << 6) | (((lane >> 4) & 1) << 5) | (((lane >> 5) & 1) << 8); }
constexpr int v_rd_off(int d0, int ks, int half) { return d0 * 512 + ks * 4096 + half * 2048; }
template <int OFF> __device__ __forceinline__ s16x4 tr_read(int vb) {
  s16x4 r; asm volatile("ds_read_b64_tr_b16 %0, %1 offset:%2" : "=&v"(r) : "v"(vb), "i"(OFF) : "memory"); return r;
}
template <int D0> __device__ __forceinline__ void pv_one(f32x16& od, int vb, bf16x8 pa0, bf16x8 pa1, bf16x8 pa2, bf16x8 pa3) {
  const s16x4 l0 = tr_read<v_rd_off(D0, 0, 0)>(vb), h0 = tr_read<v_rd_off(D0, 0, 1)>(vb), l1 = tr_read<v_rd_off(D0, 1, 0)>(vb), h1 = tr_read<v_rd_off(D0, 1, 1)>(vb);
  const s16x4 l2 = tr_read<v_rd_off(D0, 2, 0)>(vb), h2 = tr_read<v_rd_off(D0, 2, 1)>(vb), l3 = tr_read<v_rd_off(D0, 3, 0)>(vb), h3 = tr_read<v_rd_off(D0, 3, 1)>(vb);
  asm volatile("s_waitcnt lgkmcnt(0)" ::: "memory"); SBAR();
#define PK(L, H) (bf16x8){L[0], L[1], L[2], L[3], H[0], H[1], H[2], H[3]}
  od = __builtin_amdgcn_mfma_f32_32x32x16_bf16(pa0, PK(l0, h0), od, 0, 0, 0);
  od = __builtin_amdgcn_mfma_f32_32x32x16_bf16(pa1, PK(l1, h1), od, 0, 0, 0);
  od = __builtin_amdgcn_mfma_f32_32x32x16_bf16(pa2, PK(l2, h2), od, 0, 0, 0);
  od = __builtin_amdgcn_mfma_f32_32x32x16_bf16(pa3, PK(l3, h3), od, 0, 0, 0);
#undef PK
}
__device__ __forceinline__ void pv_d0(f32x16* o, int vb, bf16x8 pa0, bf16x8 pa1, bf16x8 pa2, bf16x8 pa3) {
  pv_one<0>(o[0], vb, pa0, pa1, pa2, pa3); pv_one<1>(o[1], vb, pa0, pa1, pa2, pa3); pv_one<2>(o[2], vb, pa0, pa1, pa2, pa3); pv_one<3>(o[3], vb, pa0, pa1, pa2, pa3);
}

__device__ __forceinline__ void attn_unit(gbf16* Zq, gbf16* Oq, const gbf16* Zk, const gbf16* Zv, int seq_row0, int nb, int nblk, int g, int hp, const gf32* sink16, LAS char* lds, int wave_s) {
  const int tid = make_tid(wave_s), wid = __builtin_amdgcn_readfirstlane(tid >> 6), lane = tid & 63, r32 = lane & 31, hi = lane >> 5;
  LAS char* V_lds = lds; LAS char* K_lds = lds + 2 * SHM_V;
  LAS float* ws = (LAS float*)(lds + 2 * SHM_V + 2 * SHM_K) + wid * 64; LAS float* li_l = ws; LAS float* al_l = ws + 32;
  float m_reg = -1e30f, l_reg = 0; f32x16 o[4] = {}; bf16x8 qr[8];
  const int qsub = (wid & 3) ^ ((wid >> 2) << 1);
  const int hq = 4 * g + 2 * hp + (wid >> 2), qrel0 = 32 * qsub, qi = qrel0 + r32;
#define SKIPT(t) (((t) == 0 && qsub >= 2) || ((t) == 5 && qsub < 2))
#define MASKT(t) (((t) == 0 && qsub < 2) || ((t) == 1 && qsub >= 2) || ((t) == 4 && qsub < 2) || ((t) == 5 && qsub >= 2))
  const int blk_row0 = seq_row0 + 128 * nb;
  const gbf16* Qw = Zq + (size_t)(blk_row0 + qi) * D + hq * HD + hi * 8;
#pragma unroll
  for (int d0 = 0; d0 < 8; ++d0) qr[d0] = *(const GAS bf16x8*)(Qw + d0 * 16);
  const int kt_lo = (nb == 0) ? 2 : 0, kt_hi = (nb == nblk - 1) ? 4 : 6, NT = kt_hi - kt_lo;
  const gbf16* Kh = Zk + (size_t)(blk_row0 - 128 + 64 * kt_lo) * KVW + g * HD;
  const gbf16* Vh = Zv + (size_t)(blk_row0 - 128 + 64 * kt_lo) * KVW + g * HD;
  const int sr = tid >> 4, sc = (tid & 15) * 8, vst0 = v_st(sr, sc), vst1 = v_st(32 + sr, sc);
  const int vb0 = (int)(uintptr_t)V_lds + v_rd_base(lane);
  struct { bf16x8 vs0, vs1, ks0, ks1; } sr_[SDEPTH];
#define SLOAD(i, k0) do { sr_[i].vs0 = *(const GAS bf16x8*)(&Vh[(size_t)((k0) + sr) * KVW + sc]); sr_[i].vs1 = *(const GAS bf16x8*)(&Vh[(size_t)((k0) + 32 + sr) * KVW + sc]); \
    sr_[i].ks0 = *(const GAS bf16x8*)(&Kh[(size_t)((k0) + sr) * KVW + sc]); sr_[i].ks1 = *(const GAS bf16x8*)(&Kh[(size_t)((k0) + 32 + sr) * KVW + sc]); } while (0)
#define SWRITE(b, i) do { *(LAS bf16x8*)(V_lds + (b) * SHM_V + vst0) = sr_[i].vs0;          \
    *(LAS bf16x8*)(V_lds + (b) * SHM_V + vst1) = sr_[i].vs1; int kc = sc * 2;               \
    *(LAS bf16x8*)(K_lds + (b) * SHM_K + KSWZ(sr, kc)) = sr_[i].ks0;                       \
    *(LAS bf16x8*)(K_lds + (b) * SHM_K + KSWZ(32 + sr, kc)) = sr_[i].ks1; } while (0)
#define SWAIT() do { if constexpr (SDEPTH == 2) asm volatile("s_waitcnt vmcnt(4)" ::: "memory"); else asm volatile("s_waitcnt vmcnt(0)" ::: "memory"); } while (0)
#define RESC(a) do { if (__any((a) < 1.f)) { if (hi == 0) al_l[r32] = (a); asm volatile("s_waitcnt lgkmcnt(0)" ::: "memory"); \
    _Pragma("unroll") for (int d = 0; d < 4; ++d) _Pragma("unroll") for (int r = 0; r < 16; ++r) o[d][r] *= al_l[crow(r, hi)]; } } while (0)
  f32x16 pA0, pA1, pB0, pB1; float mnA, mnB, alA, alB; bf16x8 pa0, pa1, pa2, pa3;
  constexpr int SE = 0, SO = SDEPTH - 1;
  bool sA = SKIPT(kt_lo), sB = false;
  SLOAD(SE, 0); asm volatile("s_waitcnt vmcnt(0)" ::: "memory"); SWRITE(0, SE); __syncthreads();
  if (!sA) { qkt(pA0, pA1, K_lds, qr, r32, hi); if (MASKT(kt_lo)) band_mask(pA0, pA1, kt_lo, qi, hi); partialSM(pA0, pA1, m_reg, mnA, alA); } else alA = 1.f;
  SLOAD(SO, KVBLK); if constexpr (SDEPTH == 2) { if (2 < NT) SLOAD(SE, 2 * KVBLK); }
  SWAIT(); SWRITE(1, SO); __syncthreads();
  for (int j = 1; j + 1 < NT; j += 2) {
    sB = SKIPT(kt_lo + j);
    SBAR(); if (!sB) { qkt(pB0, pB1, K_lds + SHM_K, qr, r32, hi); if (MASKT(kt_lo + j)) band_mask(pB0, pB1, kt_lo + j, qi, hi); }
    if (!sA) finishSM(pA0, pA1, alA, l_reg, pa0, pa1, pa2, pa3); SBAR();
    SLOAD(SO, (j + SDEPTH) * KVBLK); SBAR();
    if (!sA) pv_d0(o, vb0, pa0, pa1, pa2, pa3);
    if (!sB) partialSM(pB0, pB1, m_reg, mnB, alB); else alB = 1.f;
    __syncthreads(); SWAIT(); SWRITE(0, SE);
    RESC(alB); __syncthreads();
    sA = SKIPT(kt_lo + j + 1);
    SBAR(); if (!sA) { qkt(pA0, pA1, K_lds, qr, r32, hi); if (MASKT(kt_lo + j + 1)) band_mask(pA0, pA1, kt_lo + j + 1, qi, hi); }
    if (!sB) finishSM(pB0, pB1, alB, l_reg, pa0, pa1, pa2, pa3); SBAR();
    if (SDEPTH == 1 || j + 3 < NT) SLOAD(SE, (j + 1 + SDEPTH) * KVBLK); SBAR();
    if (!sB) pv_d0(o, vb0 + SHM_V, pa0, pa1, pa2, pa3);
    if (!sA) partialSM(pA0, pA1, m_reg, mnA, alA); else alA = 1.f;
    __syncthreads(); SWAIT(); SWRITE(1, SO);
    RESC(alA); __syncthreads();
  }
  sB = SKIPT(kt_lo + NT - 1);
  SBAR(); if (!sB) { qkt(pB0, pB1, K_lds + SHM_K, qr, r32, hi); if (MASKT(kt_lo + NT - 1)) band_mask(pB0, pB1, kt_lo + NT - 1, qi, hi); }
  if (!sA) finishSM(pA0, pA1, alA, l_reg, pa0, pa1, pa2, pa3); SBAR();
  if (!sA) pv_d0(o, vb0, pa0, pa1, pa2, pa3);
  if (!sB) partialSM(pB0, pB1, m_reg, mnB, alB); else alB = 1.f;
  __syncthreads(); RESC(alB);
  if (!sB) { finishSM(pB0, pB1, alB, l_reg, pa0, pa1, pa2, pa3); SBAR();
    pv_d0(o, vb0 + SHM_V, pa0, pa1, pa2, pa3); }
  { constexpr float C = SCALE * 1.4426950408889634f; l_reg += __builtin_amdgcn_exp2f(sink16[hq] * 1.4426950408889634f - m_reg * C); }
  if (hi == 0) li_l[r32] = l_reg; asm volatile("s_waitcnt lgkmcnt(0)" ::: "memory");
  float rli[16];
#pragma unroll
  for (int r = 0; r < 16; ++r) rli[r] = __builtin_amdgcn_rcpf(li_l[crow(r, hi)]);
  const int odd = r32 & 1;
  const unsigned psel = odd ? 0x03020706u : 0x05040100u;
  gbf16* Owl = Oq + (size_t)(blk_row0 + qrel0 + 4 * hi + odd) * D + hq * HD + (r32 & ~1);
#pragma unroll
  for (int q = 0; q < 8; ++q) { const int rb = ((2 * q) & 3) + 8 * ((2 * q) >> 2);
#pragma unroll
    for (int d0 = 0; d0 < 4; ++d0) {
      unsigned p; asm volatile("v_cvt_pk_bf16_f32 %0, %1, %2\n\ts_nop 1" : "=v"(p) : "v"(o[d0][2 * q] * rli[2 * q]), "v"(o[d0][2 * q + 1] * rli[2 * q + 1]));
      const unsigned pn = (unsigned)__builtin_amdgcn_update_dpp(0, (int)p, 0xB1, 0xF, 0xF, true);
      *(GAS unsigned*)(Owl + (size_t)rb * D + d0 * 32) = __builtin_amdgcn_perm(pn, p, psel); } }
#undef SLOAD
#undef SWRITE
#undef SWAIT
#undef RESC
#undef SKIPT
#undef MASKT
  __syncthreads();
}

__device__ __forceinline__ void sgu_stats_unit(const gbf16* SV, gf32* stats, int r0, int wave_s) {
  const int tid = make_tid(wave_s), wid = tid >> 6, lane = tid & 63;
#pragma unroll 1
  for (int rb = 0; rb < 16; rb += 4) {
    u32x4 w[4][4];
#pragma unroll
    for (int q = 0; q < 4; ++q)
#pragma unroll
      for (int j = 0; j < 4; ++j) w[q][j] = *(const GAS u32x4*)(SV + (size_t)(r0 + 16 * wid + rb + q) * D + lane * 8 + j * 512);
#pragma unroll
    for (int q = 0; q < 4; ++q) {
      float v[32];
#pragma unroll
      for (int j = 0; j < 4; ++j) { const u32x4 x = w[q][j];
        v[8 * j + 0] = bflo(x.x); v[8 * j + 1] = bfhi(x.x); v[8 * j + 2] = bflo(x.y); v[8 * j + 3] = bfhi(x.y); v[8 * j + 4] = bflo(x.z); v[8 * j + 5] = bfhi(x.z); v[8 * j + 6] = bflo(x.w); v[8 * j + 7] = bfhi(x.w); }
      float s = 0.f;
#pragma unroll
      for (int j = 0; j < 32; ++j) s += v[j];
      const float mean = wave_sum(s) * (1.0f / 2048.0f); float qq = 0.f;
#pragma unroll
      for (int j = 0; j < 32; ++j) { const float d = v[j] - mean; qq += d * d; }
      const float rstd = 1.0f / sqrtf(wave_sum(qq) * (1.0f / 2048.0f) + LN_EPS);
      if (lane == 0) *(GAS f32x2*)(stats + 2 * (size_t)(r0 + 16 * wid + rb + q)) = (f32x2){mean, rstd};
    }
  }
}

__device__ __forceinline__ void sgu_phase(const gbf16* SV, gbf16* U, gbf16* UO, const gf32* stats, const gbf16* swb  , const gf32* sb  ,
                                          const gf32* lng, const gf32* lnb, LAS char* lds, int wave_s, int G, int rev = 0) {
  const int tid = make_tid(wave_s), wid = tid >> 6, lane = tid & 63, r32 = lane & 31, hi = lane >> 5;
  const int sr = tid >> 4, sc = (tid & 15) * 8, k4 = (tid & 15) * 4;
  const int pb = wid & 3, dh = wid >> 2;
  constexpr int NU = 320 * 16, ZT_OFF = 65536, ZT_LD = 132;
  LAS float* Zt = (LAS float*)(lds + ZT_OFF);
  int idx = blockIdx.x;
  if (idx >= NU) return;
  u32x4 svr[4]; f32x2 str[4]; bf16x8 pan[8];
#define SGU_MAP(ix) (rev ? NU - 1 - (ix) : (ix))
#define SGU_ISSUE(ix) do { const int ch_ = SGU_MAP(ix) >> 4, g_ = SGU_MAP(ix) & 15, r0_ = ch_ * 128; \
    _Pragma("unroll") for (int i = 0; i < 4; ++i) { svr[i] = *(const GAS u32x4*)(SV + (size_t)(r0_ + sr + 32 * i) * D + g_ * 128 + sc); str[i] = *(const GAS f32x2*)(stats + 2 * (size_t)(r0_ + sr + 32 * i)); } \
    const gbf16* wp_ = swb + ((size_t)g_ * 128 + 32 * pb + r32) * 128 + 8 * hi; \
    _Pragma("unroll") for (int s = 0; s < 8; ++s) pan[s] = *(const GAS bf16x8*)(wp_ + 16 * s); } while (0)
  SGU_ISSUE(idx);
#pragma unroll 1
  for (int it = 0;; ++it) {
    const int g = SGU_MAP(idx) & 15, r0 = (SGU_MAP(idx) >> 4) * 128;
    LAS char* vbuf = lds + (it & 1) * 32768;
    { const f32x4 ga = *(const GAS f32x4*)(lng + g * 128 + sc), gb2 = *(const GAS f32x4*)(lng + g * 128 + sc + 4), ba = *(const GAS f32x4*)(lnb + g * 128 + sc), bb = *(const GAS f32x4*)(lnb + g * 128 + sc + 4);
#pragma unroll
      for (int i = 0; i < 4; ++i) { const int row = sr + 32 * i; const u32x4 w = svr[i]; const float mean = str[i].x, rstd = str[i].y;
        const float x[8] = { bflo(w.x), bfhi(w.x), bflo(w.y), bfhi(w.y), bflo(w.z), bfhi(w.z), bflo(w.w), bfhi(w.w) };
        float y[8];
#pragma unroll
        for (int e = 0; e < 4; ++e) { y[e] = (x[e] - mean) * rstd * ga[e] + ba[e]; y[4 + e] = (x[4 + e] - mean) * rstd * gb2[e] + bb[e]; }
        u32x4 ow; ow.x = cvt_pk_bf16(y[0], y[1]); ow.y = cvt_pk_bf16(y[2], y[3]); ow.z = cvt_pk_bf16(y[4], y[5]); ow.w = cvt_pk_bf16(y[6], y[7]);
        *(LAS u32x4*)(vbuf + (row >> 6) * SHM_V + v_st(row & 63, sc)) = ow; } }
    bf16x8 pa[8];
#pragma unroll
    for (int s = 0; s < 8; ++s) pa[s] = pan[s];
    u32x2 ur[4][2]; float bias[4];
#pragma unroll
    for (int j = 0; j < 4; ++j) { const gbf16* up = U + (size_t)(r0 + sr + 32 * j) * D + g * 128 + k4;
      ur[j][0] = *(const GAS u32x2*)up; ur[j][1] = *(const GAS u32x2*)(up + 64); bias[j] = sb[g * 128 + sr + 32 * j]; }
    const int nidx = idx + G; const bool has_next = nidx < NU;
    if (has_next) SGU_ISSUE(nidx);
    __syncthreads();
    const int vb0 = (int)(uintptr_t)vbuf + v_rd_base(lane) + dh * 1024;
    f32x16 o0 = {}, o1 = {};
    pv_one<0>(o0, vb0, pa[0], pa[1], pa[2], pa[3]); pv_one<1>(o1, vb0, pa[0], pa[1], pa[2], pa[3]);
    pv_one<0>(o0, vb0 + SHM_V, pa[4], pa[5], pa[6], pa[7]); pv_one<1>(o1, vb0 + SHM_V, pa[4], pa[5], pa[6], pa[7]);
#pragma unroll
    for (int r = 0; r < 16; ++r) { const int p = 32 * pb + crow(r, hi);
      Zt[p * ZT_LD + 64 * dh + r32] = o0[r]; Zt[p * ZT_LD + 64 * dh + 32 + r32] = o1[r]; }
    __syncthreads();
#pragma unroll
    for (int j = 0; j < 4; ++j) { const int row = sr + 32 * j; gbf16* up = UO + (size_t)(r0 + row) * D + g * 128 + k4;
#pragma unroll
      for (int h = 0; h < 2; ++h) { const f32x4 z = *(const LAS f32x4*)(Zt + row * ZT_LD + 64 * h + k4); const u32x2 uw = ur[j][h];
        u32x2 ow; ow.x = cvt_pk_bf16(bflo(uw.x) * (z[0] + bias[j]), bfhi(uw.x) * (z[1] + bias[j])); ow.y = cvt_pk_bf16(bflo(uw.y) * (z[2] + bias[j]), bfhi(uw.y) * (z[3] + bias[j]));
        *(GAS u32x2*)(up + 64 * h) = ow; } }
    if (!has_next) break;
    idx = nidx;
  }
#undef SGU_ISSUE
#undef SGU_MAP
  __syncthreads();
}
#undef KSWZ
#undef SBAR
}

#define XB_TMO      128
#define XB_XCNT(j)  (256  + 64 * (j))
#define XB_XSUB(j)  (1280 + 64 * (j))
#define XB_XGEN(j)  (2304 + 64 * (j))
#define XB_TOP      3328
#define XB_TOPGEN   3392
#define XCD_BAR_WORDS 3456
#define XB_SPIN_CAP (1u << 20)
__device__ __forceinline__ unsigned xb_ld(unsigned* p)              { return __hip_atomic_load(p, __ATOMIC_RELAXED, __HIP_MEMORY_SCOPE_AGENT); }
__device__ __forceinline__ unsigned xb_add(unsigned* p, unsigned v) { return __hip_atomic_fetch_add(p, v, __ATOMIC_RELAXED, __HIP_MEMORY_SCOPE_AGENT); }
__device__ __forceinline__ unsigned xb_xcc_id() { return (unsigned)__builtin_amdgcn_s_getreg((3 << 11) | 20) & 0xFu; }
#define XB_SPIN(cond, bar) do { unsigned _sp = 0; while (cond) { __builtin_amdgcn_s_sleep(1); \
    if ((++_sp & 255u) == 0u) { if (xb_ld(&(bar)[XB_TMO])) break; if (_sp > XB_SPIN_CAP) { atomicAdd(&(bar)[XB_TMO], 1u); break; } } } } while (0)
struct XcdBarrier { unsigned* bar; unsigned x; volatile LAS unsigned* st; };
__device__ __forceinline__ XcdBarrier xcd_barrier_post(unsigned* bar, volatile LAS unsigned* st) {
    XcdBarrier b; b.bar = bar; b.x = xb_xcc_id(); b.st = st;
    if (make_tid(wg_wave_index()) == 0) (void)xb_add(&bar[XB_XCNT(b.x)], 1u);
    return b;
}
__device__ __forceinline__ void xcd_barrier_complete(unsigned* bar, unsigned x, unsigned& nloc, unsigned& nx) {
    const unsigned G = gridDim.x * gridDim.y * gridDim.z;
    unsigned sum, cnt, mine, sp = 0u;
    for (;;) {
        sum = 0u; cnt = 0u; mine = 0u;
#pragma unroll 1
        for (unsigned j = 0; j < 16; ++j) { const unsigned c = xb_ld(&bar[XB_XCNT(j)]); sum += c; cnt += (c > 0u) ? 1u : 0u; mine = (j == x) ? c : mine; }
        if (sum == G) break;
        __builtin_amdgcn_s_sleep(1);
        if ((++sp & 255u) == 0u) { if (xb_ld(&bar[XB_TMO])) break; if (sp > XB_SPIN_CAP) { atomicAdd(&bar[XB_TMO], 1u); break; } }
    }
    nloc = mine > 0u ? mine : 1u; nx = cnt > 0u ? cnt : 1u;
}
__device__ __forceinline__ void xcd_barrier(const XcdBarrier& b, int wave_s) {
    asm volatile("s_waitcnt vmcnt(0)" ::: "memory");
    __syncthreads();
    if (make_tid(wave_s) == 0) {
        unsigned* bar = b.bar; asm volatile("" : "+s"(bar));
        __builtin_amdgcn_s_waitcnt(0);
        unsigned nloc = b.st[0], nx = b.st[1];
        if (nloc == 0u) { xcd_barrier_complete(bar, b.x, nloc, nx); b.st[0] = nloc; b.st[1] = nx; }
        const unsigned old = xb_add(&bar[XB_XSUB(b.x)], 1u);
        const unsigned gen = old / nloc;
        if (old + 1u == (gen + 1u) * nloc) {
            __builtin_amdgcn_fence(__ATOMIC_RELEASE, "agent");
            asm volatile("s_waitcnt vmcnt(0)" ::: "memory");
            const unsigned og = xb_add(&bar[XB_TOP], 1u);
            const unsigned tg = og / nx;
            if (og + 1u == (tg + 1u) * nx) xb_add(&bar[XB_TOPGEN], 1u);
            else XB_SPIN(xb_ld(&bar[XB_TOPGEN]) == tg, bar);
            __builtin_amdgcn_fence(__ATOMIC_ACQUIRE, "agent");
            xb_add(&bar[XB_XGEN(b.x)], 1u);
            asm volatile("s_waitcnt vmcnt(0)" ::: "memory");
        } else {
            XB_SPIN(xb_ld(&bar[XB_XGEN(b.x)]) == gen, bar);
            __builtin_amdgcn_fence(__ATOMIC_ACQUIRE, "agent");
            asm volatile("s_waitcnt vmcnt(0)" ::: "memory");
        }
    }
    __syncthreads();
}

struct Params {
    const float* x_prompt; const float* x_sample; const float* c_prompt; const float* c_sample;
    const float* w_ada; const float* b_ada; const float* ln_g; const float* ln_b;
    const float* ffn1_w_in; const float* ffn1_w_out; const float* w_mix_in; const float* attn_sink;
    const float* sgu_ln_g; const float* sgu_ln_b; const float* sgu_w; const float* sgu_b;
    const float* w_br_attn; const float* w_br_sgu; const float* w_mix_out; const float* ffn2_w_in; const float* ffn2_w_out;
    float* out; unsigned char* ws;
    float inv_freq[64];
    int ph_lo, ph_hi;
};

__device__ __forceinline__ int srcmap(int kind, int n) {
    if (kind == 0) return n;
    if (kind == 1) { const int t = n >> 8, j = n & 255; return j < 128 ? 128 * t + j : DFF + 128 * t + (j - 128); }
    if (n < ZU) return OFF_Q + (n & ~127) + dperm(n & 127);
    if (n < ZSV) return OFF_U + (n - ZU);
    if (n < ZGA) return OFF_SV + (n - ZSV);
    if (n < ZGB) return OFF_GA + (n - ZGA);
    if (n < ZK) return OFF_GB + (n - ZGB);
    if (n < ZV) { const int m = n - ZK; return OFF_K + (m & ~127) + dperm(m & 127); }
    return OFF_V + (n - ZV);
}
struct CvItem { const gf32* W; gbf16* WT; int K, N, kind, item, ldk; };
__device__ __forceinline__ void cv_load(const CvItem& c, int lane, float (&wv)[32]) {
    const int nblk = c.N / 32, kb = c.item / nblk, nb = c.item % nblk, k0 = 64 * kb, n0 = 32 * nb;
    const int scol = srcmap(c.kind, n0 + (lane & 31));
#pragma unroll
    for (int i = 0; i < 32; ++i) wv[i] = c.W[(size_t)(k0 + 2 * i + (lane >> 5)) * c.N + scol];
}
__device__ __forceinline__ void cv_store(const CvItem& c, int lane, LAS float* scr, const float (&wv)[32]) {
    const int nblk = c.N / 32, kb = c.item / nblk, nb = c.item % nblk, k0 = 64 * kb, n0 = 32 * nb;
#pragma unroll
    for (int i = 0; i < 32; ++i) scr[(2 * i + (lane >> 5)) * 33 + (lane & 31)] = wv[i];
    asm volatile("s_waitcnt lgkmcnt(0)" ::: "memory");
    const int cc = lane & 7;
#pragma unroll
    for (int j = 0; j < 4; ++j) { const int n = (lane >> 3) + 8 * j; const LAS float* s = scr + (8 * cc) * 33 + n;
        u32x4 o; o.x = cvt_pk_bf16(s[0 * 33], s[1 * 33]); o.y = cvt_pk_bf16(s[2 * 33], s[3 * 33]); o.z = cvt_pk_bf16(s[4 * 33], s[5 * 33]); o.w = cvt_pk_bf16(s[6 * 33], s[7 * 33]);
        *(GAS u32x4*)(c.WT + (size_t)(n0 + n) * c.ldk + k0 + 8 * cc) = o; }
    asm volatile("s_waitcnt lgkmcnt(0)" ::: "memory");
}
__device__ __forceinline__ void cv_decode(const Params& P, int l, gbf16* wt, int it, CvItem& c) {
    constexpr int I_FIN = (D / 64) * (NIN / 32), I_FOUT = (DFF / 64) * (D / 32), I_SQ = (D / 64) * (D / 32);
    int r = it;
    if (r < I_FIN) { c = CvItem{(const gf32*)P.ffn1_w_in + (size_t)l * D * NIN, wt + WT_FFN1_IN / 2, D, NIN, 1, r, D}; return; } r -= I_FIN;
    if (r < I_FOUT) { c = CvItem{(const gf32*)P.ffn1_w_out + (size_t)l * DFF * D, wt + WT_FFN1_OUT / 2, DFF, D, 0, r, DFF}; return; } r -= I_FOUT;
    if (r < I_FIN) { c = CvItem{(const gf32*)P.w_mix_in + (size_t)l * D * NIN, wt + WT_MIX_IN / 2, D, NIN, 2, r, D}; return; } r -= I_FIN;
    if (r < I_SQ) { c = CvItem{(const gf32*)P.w_br_attn + (size_t)l * D * D, wt + WT_BRA / 2, D, D, 0, r, 2 * D}; return; } r -= I_SQ;
    if (r < I_SQ) { c = CvItem{(const gf32*)P.w_br_sgu + (size_t)l * D * D, wt + WT_BRA / 2 + D, D, D, 0, r, 2 * D}; return; } r -= I_SQ;
    if (r < I_SQ) { c = CvItem{(const gf32*)P.w_mix_out + (size_t)l * D * D, wt + WT_MO / 2, D, D, 0, r, D}; return; } r -= I_SQ;
    if (r < I_FIN) { c = CvItem{(const gf32*)P.ffn2_w_in + (size_t)l * D * NIN, wt + WT_FFN2_IN / 2, D, NIN, 1, r, D}; return; } r -= I_FIN;
    c = CvItem{(const gf32*)P.ffn2_w_out + (size_t)l * DFF * D, wt + WT_FFN2_OUT / 2, DFF, D, 0, r, DFF};
}
#ifndef CV_TAIL_PCT
#define CV_TAIL_PCT 60
#endif
__device__ __forceinline__ void convert_group(const Params& P, int l, int grp, int part, LAS unsigned char* lds, int wave_s, int worker, int nworkers) {
    const int tid_ = make_tid(wave_s);
    const int lane = tid_ & 63, wave = __builtin_amdgcn_readfirstlane(tid_ >> 6), gw = worker * 8 + wave, NGW = nworkers * 8;
    LAS float* scr = (LAS float*)(lds + wave * 8704);
    gu8* wsb = (gu8*)P.ws; asm volatile("" : "+s"(wsb));
    gbf16* wt = (gbf16*)(wsb + WS_WT);
    constexpr int I_FIN = (D / 64) * (NIN / 32), I_FOUT = (DFF / 64) * (D / 32), I_SQ = (D / 64) * (D / 32);
    constexpr int E1 = I_FIN + I_FOUT, E2 = E1 + I_FIN + 3 * I_SQ, E3 = E2 + I_FIN + I_FOUT;
    const int g_lo = grp == 1 ? 0 : grp == 2 ? E1 : E2, g_hi = grp == 1 ? E1 : grp == 2 ? E2 : E3;
    const int cut = g_lo + (int)((long)(g_hi - g_lo) * CV_TAIL_PCT / 100);
    const int it_lo = part < 0 ? g_lo : part == 0 ? g_lo : cut, it_hi = part < 0 ? g_hi : part == 0 ? cut : g_hi;
    int it = it_lo + gw; if (it >= it_hi) return;
    CvItem cur, nxt; float wvn[32];
    cv_decode(P, l, wt, it, cur); cv_load(cur, lane, wvn);
#pragma unroll 1
    for (;;) {
        float wv[32];
#pragma unroll
        for (int i = 0; i < 32; ++i) wv[i] = wvn[i];
        const int itn = it + NGW; const bool has_next = itn < it_hi;
        if (has_next) { cv_decode(P, l, wt, itn, nxt); cv_load(nxt, lane, wvn); }
        cv_store(cur, lane, scr, wv);
        if (!has_next) break;
        cur = nxt; it = itn;
    }
}
__device__ __forceinline__ void convert_in_tail(const Params& P, int l, int grp, LAS unsigned char* lds, int wave_s, int G, int c) {
    constexpr int nwg = (M / 256) * (NIN / 256);
    const int rem = nwg % G;
    if (rem == 0) convert_group(P, l, grp, 0, lds, wave_s, c, G);
    else if (c >= rem) convert_group(P, l, grp, 0, lds, wave_s, c - rem, G - rem);
}
__device__ __forceinline__ void sincos_d(double x, double& s, double& c) {
    const double q = rint(x * 0.63661977236758134308);
    double r = fma(-q, 1.57079632673412561417e+00, x); r = fma(-q, 6.07710050650619224932e-11, r);
    const double r2 = r * r;
    const double sp = r + r * r2 * (-1.66666666666666324348e-01 + r2 * (8.33333333332248946124e-03 + r2 * (-1.98412698298579493134e-04 + r2 * (2.75573137070700676789e-06 + r2 * (-2.50507602534068634195e-08 + r2 * 1.58969099521155010221e-10)))));
    const double cp = 1.0 - 0.5 * r2 + r2 * r2 * (4.16666666666666019037e-02 + r2 * (-1.38888888888741095749e-03 + r2 * (2.48015872894767294178e-05 + r2 * (-2.75573143513906633035e-07 + r2 * (2.08757232129817482790e-09 + r2 * -1.13596475577881948265e-11)))));
    const int n = ((int)q) & 3;
    s = (n == 0) ? sp : (n == 1) ? cp : (n == 2) ? -sp : -cp;
    c = (n == 0) ? cp : (n == 1) ? -sp : (n == 2) ? -cp : sp;
}

template <int MODE>
__device__ __forceinline__ void row_phase(const Params& P, LAS unsigned char* lds, const gf32* lng, const gf32* lnb, const gf32* modl_  , int jshift, int wave_s, int rev = 0) {
    const int tid = make_tid(wave_s), lane = tid & 63, wave = __builtin_amdgcn_readfirstlane(tid >> 6);
    LAS float* G = (LAS float*)lds; LAS float* Bv = G + 2048; LAS float* SC = Bv + 2048; LAS float* SH = SC + 2048;
    gu8* wsb = (gu8*)P.ws; gf32* xout = (gf32*)P.out; asm volatile("" : "+s"(wsb), "+s"(xout));
    gbf16* hbuf = (gbf16*)(wsb + WS_H); gf32* rsb = (gf32*)(wsb + WS_RS); const GAS unsigned short* ybuf = (const GAS unsigned short*)(wsb + WS_Y);
    __syncthreads();
    if (MODE != 0) { for (int i = tid; i < 2048; i += 512) { G[i] = lng[i]; Bv[i] = lnb[i]; } }
    int curb = -1;
    constexpr int NL = (MODE == 0) ? 8 : 4;
    u32x4 nv[NL], nv2[NL];
#define ROW_TT(q_) ((int)blockIdx.x + ((q_) >> 2) * (int)gridDim.x)
#define ROW_AT(q_) (ROW_TT(q_) < M / 32 ? ((rev ? (M / 32 - 1 - ROW_TT(q_)) : ROW_TT(q_)) * 32 + wave * 4 + ((q_) & 3)) : M)
#define ROW_LOAD(dst, row_) do { if (MODE == 0) { const gf32* src_ = ((row_) < MP) ? (const gf32*)P.x_prompt + (size_t)(row_) * D : (const gf32*)P.x_sample + (size_t)((row_) - MP) * D; \
        _Pragma("unroll") for (int j = 0; j < NL; ++j) dst[j] = *(const GAS u32x4*)(src_ + 4 * (lane + 64 * j)); } \
      else { const GAS unsigned short* src_ = ybuf + (size_t)(row_) * D; _Pragma("unroll") for (int j = 0; j < NL; ++j) dst[j] = *(const GAS u32x4*)(src_ + 8 * (lane + 64 * j)); } } while (0)
    { const int r0_ = ROW_AT(0), r1_ = ROW_AT(1); if (r0_ < M) ROW_LOAD(nv, r0_); if (r1_ < M) ROW_LOAD(nv2, r1_); }
    int qidx = 0;
    for (int t = blockIdx.x; t < M / 32; t += gridDim.x) {
        const int row0 = (rev ? (M / 32 - 1 - t) : t) * 32, b = batch_of(row0);
        if (b != curb) {
            __syncthreads();
            if (MODE != 2) { const gf32* sh = modl_ + ((size_t)b * NMOD + jshift) * D; const gf32* sc = sh + D;
                for (int i = tid; i < 2048; i += 512) { SH[i] = sh[i]; SC[i] = 1.0f + sc[i]; } }
            __syncthreads(); curb = b;
        }
#pragma unroll 1
        for (int rr = 0; rr < 4; ++rr, ++qidx) {
            const int row = row0 + wave * 4 + rr;
            u32x4 cw[NL];
#pragma unroll
            for (int j = 0; j < NL; ++j) { cw[j] = nv[j]; nv[j] = nv2[j]; }
            { const int nrow = ROW_AT(qidx + 2); if (nrow < M) ROW_LOAD(nv2, nrow); }
            f32x4 v[8];
            if (MODE == 0) {
#pragma unroll
                for (int j = 0; j < 8; ++j) v[j] = __builtin_bit_cast(f32x4, cw[j]);
            } else {
#pragma unroll
                for (int j = 0; j < 4; ++j) { v[2 * j] = (f32x4){f16lo(cw[j].x), f16hi(cw[j].x), f16lo(cw[j].y), f16hi(cw[j].y)}; v[2 * j + 1] = (f32x4){f16lo(cw[j].z), f16hi(cw[j].z), f16lo(cw[j].w), f16hi(cw[j].w)}; }
            }
#define CBASE(jj) ((MODE == 0) ? 4 * (lane + 64 * (jj)) : 8 * (lane + 64 * ((jj) >> 1)) + 4 * ((jj) & 1))
            if (MODE != 0) {
                float s = 0.f;
#pragma unroll
                for (int j = 0; j < 8; ++j) s += (v[j][0] + v[j][1]) + (v[j][2] + v[j][3]);
                const float mean = wave_sum(s) * (1.0f / D); float q = 0.f;
#pragma unroll
                for (int j = 0; j < 8; ++j) { v[j] = v[j] - mean; q += (v[j][0] * v[j][0] + v[j][1] * v[j][1]) + (v[j][2] * v[j][2] + v[j][3] * v[j][3]); }
                const float rstd = 1.0f / sqrtf(wave_sum(q) * (1.0f / D) + LN_EPS);
                if (MODE == 1 && lane == 0) *(GAS f32x2*)(rsb + 2 * (size_t)row) = (f32x2){mean, rstd};
#pragma unroll
                for (int j = 0; j < 8; ++j) { const int c = CBASE(j);
                    const f32x4 gg = *(const LAS f32x4*)(G + c), bb = *(const LAS f32x4*)(Bv + c);
                    v[j] = v[j] * rstd * gg + bb;
                    if (MODE == 2) *(GAS f32x4*)(xout + (size_t)row * D + c) = v[j]; }
            }
            if (MODE != 2) {
                if (MODE == 0) {
#pragma unroll
                    for (int j = 0; j < 8; ++j) { const int c = CBASE(j);
                        const f32x4 sc = *(const LAS f32x4*)(SC + c), sh = *(const LAS f32x4*)(SH + c);
                        const f32x4 h = v[j] * sc + sh;
                        u32x2 w; w.x = cvt_pk_bf16(h[0], h[1]); w.y = cvt_pk_bf16(h[2], h[3]);
                        *(GAS u32x2*)(hbuf + (size_t)row * D + c) = w; }
                } else {
#pragma unroll
                    for (int j = 0; j < 4; ++j) { const int c = CBASE(2 * j);
                        const f32x4 sc0 = *(const LAS f32x4*)(SC + c), sh0 = *(const LAS f32x4*)(SH + c), sc1 = *(const LAS f32x4*)(SC + c + 4), sh1 = *(const LAS f32x4*)(SH + c + 4);
                        const f32x4 h0 = v[2 * j] * sc0 + sh0, h1 = v[2 * j + 1] * sc1 + sh1;
                        u32x4 w; w.x = cvt_pk_bf16(h0[0], h0[1]); w.y = cvt_pk_bf16(h0[2], h0[3]); w.z = cvt_pk_bf16(h1[0], h1[1]); w.w = cvt_pk_bf16(h1[2], h1[3]);
                        *(GAS u32x4*)(hbuf + (size_t)row * D + c) = w; }
                }
            }
#undef CBASE
        }
    }
#undef ROW_AT
#undef ROW_TT
#undef ROW_LOAD
    __syncthreads();
}

__global__ void __launch_bounds__(512, 2) hybrid_fwd(Params P) {
    extern __shared__ __attribute__((aligned(16))) unsigned char lds_raw[];
    LAS unsigned char* lds = (LAS unsigned char*)lds_raw;
    const int G = gridDim.x;
    const int wave_s_ = wg_wave_index();
    volatile LAS unsigned* MISC = (volatile LAS unsigned*)(lds + MISC_OFF);
    { const int t0 = make_tid(wave_s_); if (t0 < 8) MISC[t0] = 0u; }
    __syncthreads();
    unsigned* ctl = (unsigned*)(P.ws + WS_CTL);
    XcdBarrier bar; bar.bar = ctl + CW_BAR; bar.x = 0; bar.st = MISC;
    if (!MK_PER_PHASE) bar = xcd_barrier_post(ctl + CW_BAR, MISC);
    const int lo = P.ph_lo, hi = P.ph_hi;
    int ph = 0, dirx = 1;
#ifndef PHMASK
#define PHMASK 0xFFFFF
#endif
#define SITE(id) (((PHMASK) >> (id)) & 1)
#define PH_ON (ph >= lo && ph < hi)
#define PH_REV (dirx)
#define PH_END do { if (!MK_PER_PHASE && ph + 1 < hi) xcd_barrier(bar, wave_s_); } while (0)
#define PH_LOCALS gu8* wsb = (gu8*)P.ws; int wv = wave_s_; asm volatile("" : "+s"(wsb), "+s"(wv)); const int wave_s = wv; \
    gf32* mod = (gf32*)(wsb + WS_MOD); gf32* cosT = (gf32*)(wsb + WS_COS); gf32* sinT = (gf32*)(wsb + WS_SIN); gbf16* swb = (gbf16*)(wsb + WS_SW); gf32* stats = (gf32*)(wsb + WS_ST); \
    gbf16* wt = (gbf16*)(wsb + WS_WT); gbf16* hbuf = (gbf16*)(wsb + WS_H); gbf16* zbuf = (gbf16*)(wsb + WS_Z); \
    (void)mod; (void)cosT; (void)sinT; (void)swb; (void)wt; (void)hbuf; (void)zbuf; (void)wave_s; (void)stats;
#define modl (mod + (size_t)l * NB * NMOD * D)

    if (SITE(0) && PH_ON) { PH_LOCALS
        convert_group(P, 0, 1, -1, lds, wave_s, (int)blockIdx.x, G);
        const int tid = make_tid(wave_s), lane = tid & 63, wave = __builtin_amdgcn_readfirstlane(tid >> 6);
        const int gt = blockIdx.x * 512 + tid, NGT = G * 512;
#pragma unroll 1
        for (int rep = DUP(9) ? 0 : 1; rep < 2; ++rep) {
        for (int i = gt; i < DEPTH * 16 * 128 * 128 / 2; i += NGT) { const f32x2 v = *(const GAS f32x2*)((const gf32*)P.sgu_w + 2 * (size_t)i); ((GAS unsigned*)swb)[i] = cvt_pk_bf16(v.x, v.y); }
        for (int i = gt; i < 8192 * 64; i += NGT) { const int pos = i >> 6, j = i & 63; const float ang = (float)pos * P.inv_freq[j]; double s, c; sincos_d((double)ang, s, c); cosT[i] = (float)c; sinT[i] = (float)s; }
        __syncthreads();
        LAS float* scv = (LAS float*)lds;
        LAS float* red = (LAS float*)(lds + 49152);
        for (int i = tid; i < NB * D; i += 512) { const int b = i >> 11, k = i & 2047; const float cv = (b < 2) ? ((const gf32*)P.c_prompt)[b * D + k] : ((const gf32*)P.c_sample)[(b - 2) * D + k]; scv[i] = silu_f(cv); }
        __syncthreads();
        constexpr int NCH = NMOD * D / 64;
        for (int it = blockIdx.x; it < DEPTH * NCH; it += G) {
            const int l = it / NCH, ch = it % NCH; const gf32* wp = (const gf32*)P.w_ada + (size_t)l * D * (NMOD * D) + (size_t)(256 * wave) * (NMOD * D) + ch * 64 + lane;
            float a[NB] = {0.f, 0.f, 0.f, 0.f, 0.f, 0.f};
#pragma unroll 1
            for (int k0 = 0; k0 < 256; k0 += 32) { float wv[32];
#pragma unroll
                for (int k = 0; k < 32; ++k) wv[k] = wp[(size_t)(k0 + k) * (NMOD * D)];
#pragma unroll
                for (int k = 0; k < 32; ++k)
#pragma unroll
                    for (int b = 0; b < NB; ++b) a[b] += scv[b * D + 256 * wave + k0 + k] * wv[k]; }
#pragma unroll
            for (int b = 0; b < NB; ++b) red[(wave * NB + b) * 64 + lane] = a[b];
            __syncthreads();
            if (tid < NB * 64) { const int b = tid >> 6, c = tid & 63; float s = 0.f;
#pragma unroll
                for (int w = 0; w < 8; ++w) s += red[(w * NB + b) * 64 + c];
                const int n = ch * 64 + c; mod[((size_t)l * NB + b) * (NMOD * D) + n] = s + ((const gf32*)P.b_ada)[(size_t)l * NMOD * D + n]; }
            __syncthreads();
        }
        if (rep == 0) xcd_barrier(bar, wave_s_); }
        PH_END;
    }
    ++ph; dirx ^= 1;
    if (SITE(1) && PH_ON) { PH_LOCALS row_phase<0>(P, lds, nullptr, nullptr, mod, 0, wave_s); if (DUP(1)) { xcd_barrier(bar, wave_s_); row_phase<0>(P, lds, nullptr, nullptr, mod, 0, wave_s); } PH_END; }
    ++ph; dirx ^= 1;

    for (int l = 0; l < DEPTH; ++l) {
        for (int half = 0; half < 2; ++half) {
            const int sub = 2 * half;
            if (SITE(2) && PH_ON) { PH_LOCALS
                pg8::Gemm g{hbuf, wt + (half ? WT_FFN2_IN : WT_FFN1_IN) / 2}; pg8::StaticOrder<NIN> S; S.init(G, (int)blockIdx.x, PH_REV);
                pg8::EpiSwiglu E{zbuf};
                pg8::gemm_phase<pg8::EpiSwiglu, NIN, D, D, true, true>(lds, g, S, E, wave_s);
                if (half == 0) convert_in_tail(P, l, 2, lds, wave_s, G, (int)blockIdx.x);
                else if (l + 1 < DEPTH) convert_in_tail(P, l + 1, 1, lds, wave_s, G, (int)blockIdx.x);
                if (DUP(2)) { xcd_barrier(bar, wave_s_); pg8::gemm_phase<pg8::EpiSwiglu, NIN, D, D, true, true>(lds, g, S, E, wave_s); }
#ifdef PROBE_TILED
                { xcd_barrier(bar, wave_s_); pg8::EpiNone E0; pg8::gemm_phase<pg8::EpiNone, NIN, D, 64, true, true, 64, 32768, 32768>(lds, g, S, E0, wave_s); }
#endif
#ifdef PROBE_ROWMAJ
                { xcd_barrier(bar, wave_s_); pg8::EpiNone E0; pg8::gemm_phase<pg8::EpiNone, NIN, D, D, true, true>(lds, g, S, E0, wave_s); }
#endif
                PH_END;
            }
            ++ph; dirx ^= 1;
            if (SITE(3) && PH_ON) { PH_LOCALS
                pg8::Gemm g{zbuf, wt + (half ? WT_FFN2_OUT : WT_FFN1_OUT) / 2}; pg8::StaticOrder<D> S; S.init(G, (int)blockIdx.x, PH_REV);
                const bool first = (l == 0 && half == 0);
                GAS unsigned short* yb = (GAS unsigned short*)(wsb + WS_Y);
                if (DUP(3)) { pg8::EpiNone E0; pg8::gemm_phase<pg8::EpiNone, D, DFF, DFF, true, true>(lds, g, S, E0, wave_s); xcd_barrier(bar, wave_s_); }
                const int pl = half ? l : l - 1, psub = half ? 1 : 2;
                const gf32* plg = (const gf32*)P.ln_g + ((size_t)(first ? 0 : pl) * 3 + psub) * D; const gf32* plb = (const gf32*)P.ln_b + ((size_t)(first ? 0 : pl) * 3 + psub) * D;
                if (first) { pg8::EpiResid<0> E{(const gf32*)P.x_prompt, (const gf32*)P.x_sample, yb, modl + (size_t)(3 * sub + 2) * D, (const gf32*)(wsb + WS_RS), plg, plb, 0.5f};
                    pg8::gemm_phase<pg8::EpiResid<0>, D, DFF, DFF, true, true>(lds, g, S, E, wave_s); }
                else { pg8::EpiResid<1> E{(const gf32*)P.x_prompt, (const gf32*)P.x_sample, yb, modl + (size_t)(3 * sub + 2) * D, (const gf32*)(wsb + WS_RS), plg, plb, 0.5f};
                    pg8::gemm_phase<pg8::EpiResid<1>, D, DFF, DFF, true, true>(lds, g, S, E, wave_s); }
                PH_END;
            }
            ++ph; dirx ^= 1;
            if (SITE(4) && PH_ON) { PH_LOCALS
                const gf32* lg = (const gf32*)P.ln_g + ((size_t)l * 3 + sub) * D; const gf32* lb = (const gf32*)P.ln_b + ((size_t)l * 3 + sub) * D;
                if (DUP(4) && !(half == 1 && l + 1 >= DEPTH)) { if (half == 0) row_phase<1>(P, lds, lg, lb, modl, 3, wave_s); else row_phase<1>(P, lds, lg, lb, modl + (size_t)NB * NMOD * D, 0, wave_s); xcd_barrier(bar, wave_s_); }
                if (half == 0) { convert_group(P, l, 2, 1, lds, wave_s, (int)blockIdx.x, G); row_phase<1>(P, lds, lg, lb, modl, 3, wave_s, PH_REV); }
                else if (l + 1 < DEPTH) { convert_group(P, l + 1, 1, 1, lds, wave_s, (int)blockIdx.x, G); row_phase<1>(P, lds, lg, lb, modl + (size_t)NB * NMOD * D, 0, wave_s, PH_REV); }
                else row_phase<2>(P, lds, lg, lb, modl, 0, wave_s, PH_REV);
                PH_END;
            }
            ++ph; dirx ^= 1;
            if (half == 1) break;
            if (SITE(5) && PH_ON) { PH_LOCALS
                pg8::Gemm g{hbuf, wt + WT_MIX_IN / 2}; pg8::StaticOrder<NIN> S; S.init(G, (int)blockIdx.x, PH_REV);
                pg8::EpiMix E{zbuf, cosT, sinT, (gf32*)P.out};
                pg8::gemm_phase<pg8::EpiMix, NIN, D, D, true, true>(lds, g, S, E, wave_s);
                convert_in_tail(P, l, 3, lds, wave_s, G, (int)blockIdx.x);
                PH_END;
            }
            ++ph; dirx ^= 1;
            if (SITE(6) && PH_ON) { PH_LOCALS
                { const int tid = make_tid(wave_s); const gf32* sp = (const gf32*)P.out;
#pragma unroll 1
                  for (int r = blockIdx.x * 512 + tid; r < M; r += G * 512) { float s1 = 0.f, s2 = 0.f;
#pragma unroll
                      for (int j = 0; j < 16; ++j) { const f32x4 p = *(const GAS f32x4*)(sp + (size_t)r * 64 + 4 * j); s1 += p[0] + p[2]; s2 += p[1] + p[3]; }
                      const float mean = s1 * (1.0f / 2048.0f), var = fmaxf(s2 * (1.0f / 2048.0f) - mean * mean, 0.f);
                      *(GAS f32x2*)(stats + 2 * (size_t)r) = (f32x2){mean, 1.0f / sqrtf(var + LN_EPS)}; } }
#pragma unroll 1
                for (int rep = DUP(6) ? 0 : 1; rep < 2; ++rep) {
#pragma unroll 1
                for (int idx_ = blockIdx.x; idx_ < 2560; idx_ += G) {
                    const int idx = PH_REV ? 2559 - idx_ : idx_;
                    const int blk = idx >> 3, gk = (idx >> 1) & 3, hp = idx & 1; int seq_row0, nb, nblk;
                    if (blk < 64) { seq_row0 = (blk >> 5) * 4096; nb = blk & 31; nblk = 32; }
                    else { const int b2 = blk - 64; seq_row0 = MP + (b2 >> 6) * 8192; nb = b2 & 63; nblk = 64; }
                    att::attn_unit(zbuf + ZB_Q, (DUP(6) && rep == 0) ? hbuf : zbuf + ZB_Q, zbuf + ZB_K, zbuf + ZB_V, seq_row0, nb, nblk, gk, hp, (const gf32*)P.attn_sink + l * NHQ, (LAS char*)lds, wave_s);
                }
                if (rep == 0) xcd_barrier(bar, wave_s_); }
                PH_END;
            }
            ++ph;
            if (SITE(7) && PH_ON) { PH_LOCALS
                if (DUP(7)) { att::sgu_phase(zbuf + ZB_SV, zbuf + ZB_U, hbuf, stats, swb + (size_t)l * 16 * 128 * 128, (const gf32*)P.sgu_b + (size_t)l * 16 * 128, (const gf32*)P.sgu_ln_g + (size_t)l * D, (const gf32*)P.sgu_ln_b + (size_t)l * D, (LAS char*)lds, wave_s, G); xcd_barrier(bar, wave_s_); }
                att::sgu_phase(zbuf + ZB_SV, zbuf + ZB_U, zbuf + ZB_U, stats, swb + (size_t)l * 16 * 128 * 128, (const gf32*)P.sgu_b + (size_t)l * 16 * 128, (const gf32*)P.sgu_ln_g + (size_t)l * D, (const gf32*)P.sgu_ln_b + (size_t)l * D, (LAS char*)lds, wave_s, G, PH_REV);
                PH_END;
            }
            ++ph; dirx ^= 1;
            if (SITE(8) && PH_ON) { PH_LOCALS
                pg8::Gemm g{zbuf + ZB_Q, wt + WT_BRA / 2}; pg8::StaticOrder<D> S; S.init(G, (int)blockIdx.x, PH_REV);
                pg8::EpiBranchF E{hbuf, zbuf + ZB_GA, zbuf + ZB_GB};
                pg8::gemm_phase<pg8::EpiBranchF, D, 2 * D, D, true, true, 2 * D, 128, 128, 32, (size_t)M * D * 2 - 32 * 128>(lds, g, S, E, wave_s);
                PH_END;
            }
            ++ph; dirx ^= 1;
            if (SITE(10) && PH_ON) { PH_LOCALS
                pg8::Gemm g{hbuf, wt + WT_MO / 2}; pg8::StaticOrder<D> S; S.init(G, (int)blockIdx.x, PH_REV);
                GAS unsigned short* yb = (GAS unsigned short*)(wsb + WS_Y);
                pg8::EpiResid<1> E{(const gf32*)P.x_prompt, (const gf32*)P.x_sample, yb, modl + (size_t)(3 * 1 + 2) * D, (const gf32*)(wsb + WS_RS), (const gf32*)P.ln_g + ((size_t)l * 3 + 0) * D, (const gf32*)P.ln_b + ((size_t)l * 3 + 0) * D, 1.0f};
                pg8::gemm_phase<pg8::EpiResid<1>, D, D, D, true, true>(lds, g, S, E, wave_s);
                PH_END;
            }
            ++ph; dirx ^= 1;
            if (SITE(11) && PH_ON) { PH_LOCALS
                convert_group(P, l, 3, 1, lds, wave_s, (int)blockIdx.x, G);
                row_phase<1>(P, lds, (const gf32*)P.ln_g + ((size_t)l * 3 + 1) * D, (const gf32*)P.ln_b + ((size_t)l * 3 + 1) * D, modl, 6, wave_s, PH_REV);
                if (DUP(4)) { xcd_barrier(bar, wave_s_); row_phase<1>(P, lds, (const gf32*)P.ln_g + ((size_t)l * 3 + 1) * D, (const gf32*)P.ln_b + ((size_t)l * 3 + 1) * D, modl, 6, wave_s); }
                PH_END;
            }
            ++ph; dirx ^= 1;
        }
    }
#undef PH_ON
#undef PH_END
}

constexpr int N_PHASES = 2 + DEPTH * 12;

extern "C" void kernel_launch(void* const* d_in, const int* in_sizes, int n_in, void* d_out, int out_size, void* d_ws, size_t ws_size, hipStream_t stream) {
    static int grid = 0;
    if (grid == 0) {
        if (n_in != 21 || in_sizes[0] != MP * D || in_sizes[1] != MS * D || out_size != M * D || ws_size < WS_END) {
            fprintf(stderr, "kernel_launch: shape mismatch n_in %d in0 %d in1 %d out %d ws %zu (need %zu)\n", n_in, n_in > 0 ? in_sizes[0] : -1, n_in > 1 ? in_sizes[1] : -1, out_size, ws_size, (size_t)WS_END);
            grid = -1; return; }
        int dev = 0, cus = 0;
        if (hipGetDevice(&dev) != hipSuccess || hipDeviceGetAttribute(&cus, hipDeviceAttributeMultiprocessorCount, dev) != hipSuccess) { grid = -1; return; }
        if (hipFuncSetAttribute((const void*)hybrid_fwd, hipFuncAttributeMaxDynamicSharedMemorySize, LDS_BYTES) != hipSuccess) { fprintf(stderr, "kernel_launch: hipFuncSetAttribute failed\n"); grid = -1; return; }
        int per_cu = 0;
        if (hipOccupancyMaxActiveBlocksPerMultiprocessor(&per_cu, (const void*)hybrid_fwd, 512, LDS_BYTES) != hipSuccess || per_cu < 1) {
            fprintf(stderr, "kernel_launch: occupancy query reports %d blocks per CU\n", per_cu); }
        (void)hipGetLastError();
        grid = cus;
    }
    if (grid < 0) return;
    (void)hipMemsetAsync((char*)d_ws + WS_CTL, 0, CTL_ZERO_BYTES, stream);
    Params p{};
    p.x_prompt = (const float*)d_in[0]; p.x_sample = (const float*)d_in[1]; p.c_prompt = (const float*)d_in[2]; p.c_sample = (const float*)d_in[3];
    p.w_ada = (const float*)d_in[4]; p.b_ada = (const float*)d_in[5]; p.ln_g = (const float*)d_in[6]; p.ln_b = (const float*)d_in[7];
    p.ffn1_w_in = (const float*)d_in[8]; p.ffn1_w_out = (const float*)d_in[9]; p.w_mix_in = (const float*)d_in[10]; p.attn_sink = (const float*)d_in[11];
    p.sgu_ln_g = (const float*)d_in[12]; p.sgu_ln_b = (const float*)d_in[13]; p.sgu_w = (const float*)d_in[14]; p.sgu_b = (const float*)d_in[15];
    p.w_br_attn = (const float*)d_in[16]; p.w_br_sgu = (const float*)d_in[17]; p.w_mix_out = (const float*)d_in[18]; p.ffn2_w_in = (const float*)d_in[19]; p.ffn2_w_out = (const float*)d_in[20];
    p.out = (float*)d_out; p.ws = (unsigned char*)d_ws;
    for (int j = 0; j < 64; ++j) { const float t = powf(10000.0f, (float)j / 64.0f); p.inv_freq[j] = 1.0f / t; }
#if MK_PER_PHASE
    for (int k = 0; k < N_PHASES; ++k) { p.ph_lo = k; p.ph_hi = k + 1; hipLaunchKernelGGL(hybrid_fwd, dim3(grid), dim3(512), LDS_BYTES, stream, p); }
#else
#ifdef PROBE_FIRST
    p.ph_lo = 0; p.ph_hi = PROBE_K;
    hipLaunchKernelGGL(hybrid_fwd, dim3(grid), dim3(512), LDS_BYTES, stream, p);
    (void)hipMemsetAsync((char*)d_ws + WS_CTL, 0, CTL_ZERO_BYTES, stream);
#endif
    p.ph_lo = 0; p.ph_hi = N_PHASES;
    hipLaunchKernelGGL(hybrid_fwd, dim3(grid), dim3(512), LDS_BYTES, stream, p);
#ifdef PROBE_TWICE
    (void)hipMemsetAsync((char*)d_ws + WS_CTL, 0, CTL_ZERO_BYTES, stream);
    p.ph_lo = PROBE_LO; p.ph_hi = PROBE_HI;
    hipLaunchKernelGGL(hybrid_fwd, dim3(grid), dim3(512), LDS_BYTES, stream, p);
#endif
#endif
    const hipError_t le = hipPeekAtLastError();
    if (le != hipSuccess) fprintf(stderr, "kernel_launch: launch failed: %s\n", hipGetErrorName(le));
}
```

```cpp
#include <hip/hip_runtime.h>
#include <cstdio>
#include <cstdint>
#include <cmath>

#ifndef MK_PER_PHASE
#define MK_PER_PHASE 0
#endif
#ifndef PROBE_DUP
#define PROBE_DUP 0
#endif
#define DUP(id) (((PROBE_DUP) >> (id)) & 1)

#define LAS __attribute__((address_space(3)))
#define GAS __attribute__((address_space(1)))
typedef unsigned short bf16_t;
typedef short bf16x8 __attribute__((ext_vector_type(8)));
typedef short s16x4 __attribute__((ext_vector_type(4)));
typedef float f32x4 __attribute__((ext_vector_type(4)));
typedef float f32x2 __attribute__((ext_vector_type(2)));
typedef float f32x16 __attribute__((ext_vector_type(16)));
typedef unsigned u32x4 __attribute__((ext_vector_type(4)));
typedef unsigned u32x2 __attribute__((ext_vector_type(2)));
typedef _Float16 h16x2 __attribute__((ext_vector_type(2)));
typedef GAS bf16_t gbf16;
typedef GAS float gf32;
typedef GAS unsigned char gu8;

constexpr int D = 2048, DEPTH = 2, DFF = 5632, NIN = 11264, NMOD = 9, NB = 6;
constexpr int MP = 8192, MS = 32768, M = MP + MS;
constexpr int NHQ = 16, NHKV = 4, HD = 128, KVW = NHKV * HD;
constexpr int OFF_Q = 0, OFF_K = 2048, OFF_V = 2560, OFF_U = 3072, OFF_SV = 5120, OFF_GA = 7168, OFF_GB = 9216;
constexpr int ZQ = 0, ZU = 2048, ZSV = 4096, ZGA = 6144, ZGB = 8192, ZK = 10240, ZV = 10752;
constexpr size_t ZB_Q = 0, ZB_U = (size_t)M * D, ZB_SV = 2 * (size_t)M * D, ZB_GA = 3 * (size_t)M * D, ZB_GB = 4 * (size_t)M * D, ZB_K = 5 * (size_t)M * D, ZB_V = ZB_K + (size_t)M * KVW;
constexpr float LN_EPS = 1e-5f;
constexpr float DN_ALPHA = 1.4142135623730951f;

constexpr size_t MiB = 1u << 20;
constexpr size_t WS_CTL = 0, CTL_ZERO_BYTES = 1 * MiB;
constexpr size_t WS_MOD = 1 * MiB;
constexpr size_t WS_COS = 2 * MiB, WS_SIN = 4 * MiB;
constexpr size_t WS_SW = 6 * MiB;
constexpr size_t WS_ST = 7 * MiB;
constexpr size_t WS_RS = 7 * MiB + 512 * 1024;
constexpr size_t WS_WT = 8 * MiB;
constexpr size_t WT_FFN1_IN = 0, WT_FFN1_OUT = 44 * MiB, WT_MIX_IN = 66 * MiB, WT_BRA = 110 * MiB, WT_BRS = 118 * MiB, WT_MO = 126 * MiB,
                 WT_FFN2_IN = 134 * MiB, WT_FFN2_OUT = 178 * MiB, WT_END = 200 * MiB;
constexpr size_t WS_H = WS_WT + WT_END;
constexpr size_t WS_Z = WS_H + 160 * MiB;
constexpr size_t WS_Y = WS_Z + 880 * MiB;
constexpr size_t WS_END = WS_Y + 160 * MiB;
static_assert(WT_BRS == WT_BRA + 8 * MiB && ZB_U == ZB_Q + (size_t)M * D && (size_t)M * D * 2 == 160 * MiB && (size_t)M * NIN * 2 == 880 * MiB && (size_t)NIN * D * 2 == 44 * MiB && (size_t)D * DFF * 2 == 22 * MiB && (size_t)M * 8 <= MiB, "ws map");
constexpr int CW_BAR = 4096;

constexpr int LDS_BYTES = 147456;
constexpr int MISC_OFF = 131072 + 8192;

__device__ __forceinline__ unsigned cvt_pk_bf16(float lo, float hi) { unsigned r; asm volatile("v_cvt_pk_bf16_f32 %0, %1, %2" : "=v"(r) : "v"(lo), "v"(hi)); return r; }
__device__ __forceinline__ unsigned pk_f16(float lo, float hi) { const h16x2 h = {(_Float16)lo, (_Float16)hi}; return __builtin_bit_cast(unsigned, h); }
__device__ __forceinline__ float f16lo(unsigned w) { return (float)__builtin_bit_cast(h16x2, w)[0]; }
__device__ __forceinline__ float f16hi(unsigned w) { return (float)__builtin_bit_cast(h16x2, w)[1]; }
__device__ __forceinline__ float bflo(unsigned w) { return __uint_as_float(w << 16); }
__device__ __forceinline__ float bfhi(unsigned w) { return __uint_as_float(w & 0xffff0000u); }
template <int XM> __device__ __forceinline__ float swz_xor(float v) { return __int_as_float(__builtin_amdgcn_ds_swizzle(__float_as_int(v), (XM << 10) | 0x1F)); }
__device__ __forceinline__ float wave_sum(float v) {
    v += swz_xor<1>(v); v += swz_xor<2>(v); v += swz_xor<4>(v); v += swz_xor<8>(v); v += swz_xor<16>(v);
    auto rr = __builtin_amdgcn_permlane32_swap(__float_as_uint(v), __float_as_uint(v), false, false);
    return __uint_as_float(rr[0]) + __uint_as_float(rr[1]);
}
__device__ __forceinline__ int wg_wave_index() { return __builtin_amdgcn_readfirstlane((int)(threadIdx.x >> 6)); }
__device__ __forceinline__ int make_tid(int wave_s) { int l; asm volatile("v_mbcnt_lo_u32_b32 %0, -1, 0\n\tv_mbcnt_hi_u32_b32 %0, -1, %0" : "=v"(l)); return wave_s * 64 + l; }
__device__ __forceinline__ float fast_exp2(float x) { return __builtin_amdgcn_exp2f(x); }
__device__ __forceinline__ float fast_rcp(float x) { return __builtin_amdgcn_rcpf(x); }
__device__ __forceinline__ float silu_f(float x) { return x * fast_rcp(1.0f + fast_exp2(-1.4426950408889634f * x)); }
__device__ __forceinline__ float sigmoid_f(float x) { return fast_rcp(1.0f + fast_exp2(-1.4426950408889634f * x)); }
__device__ __forceinline__ float gelu_tanh_f(float x) {
    const float x2 = x * x, p = fmaf(x2, -2.0f * 1.4426950408889634f * 0.7978845608028654f * 0.044715f, -2.0f * 1.4426950408889634f * 0.7978845608028654f);
    return x * fast_rcp(1.0f + fast_exp2(x * p));
}
__device__ __forceinline__ int batch_of(int row) { return row < MP ? (row >> 12) : 2 + ((row - MP) >> 13); }
__device__ __forceinline__ int pos_of(int row) { return row < MP ? (row & 4095) : (row & 8191); }
__host__ __device__ __forceinline__ int dperm(int p) { return 16 * (p >> 5) + 4 * ((p >> 3) & 3) + (p & 3) + 64 * ((p >> 2) & 1); }

namespace pg8 {
constexpr int BM = 256, BK = 64, HALF = 128, HTB = HALF * BK * 2, STAGE_BYTES = 8 * HTB, NXCD = 8, WGM = 8;
__host__ __device__ __forceinline__ int lds_byte(int r, int c) { const int st = (r >> 4) * 2 + (c >> 5), rr = r & 15, cc = c & 31, ob = rr * 64 + cc * 2; return st * 1024 + (ob ^ (((ob >> 9) & 1) << 5)); }
__host__ __device__ __forceinline__ void stage_rc(int b, int& R, int& C) { const int st = b / 1024, sb = b % 1024, swz = sb ^ (((sb >> 9) & 1) << 5); R = (st >> 1) * 16 + swz / 64; C = (st & 1) * 32 + (swz % 64) / 2; }
__host__ __device__ __forceinline__ int perm32(int rho) { const int n = rho >> 4, i = rho & 15; return 8 * (i >> 2) + 4 * n + (i & 3); }
struct Unit { int pm, pn; };
struct Gemm { const gbf16* A; const gbf16* Bt; };
template <int N_> struct StaticOrder {
    static constexpr int nM = M / BM, nN = N_ / BM, nwg = nM * nN;
    static constexpr int WG = (nN == 8) ? 4 : WGM;
    int G, c, rev;
    __host__ __device__ void init(int G_, int c_, int rev_ = 0) { G = G_; c = c_; rev = rev_; }
    __host__ __device__ bool next(int i, Unit& u) const {
        const long L = (long)i * G + c; if (L >= nwg) return false;
        int wgid = (int)L; { const int q = nwg / NXCD, r = nwg % NXCD, xcd = wgid % NXCD, off = wgid / NXCD; wgid = (xcd < r ? xcd * (q + 1) : r * (q + 1) + (xcd - r) * q) + off; }
        const int nig = WG * nN, gid = wgid / nig, fm = gid * WG, gsz = (nM - fm) < WG ? (nM - fm) : WG;
        u.pm = fm + ((wgid % nig) % gsz); u.pn = (wgid % nig) / gsz; if (rev) u.pm = nM - 1 - u.pm; return true;
    }
};

template <class Epi, int N, int K, int lda, bool ALIGN_EPI, bool SP2, int ldb = K, int KSA = BK * 2, int KSB = BK * 2, int TJ = 0, size_t JUMPA = 0>
__device__ __forceinline__ void gemm_phase(LAS unsigned char* lds, const Gemm g, const StaticOrder<N>& S, const Epi& E, int wave_s) {
    const int tid = make_tid(wave_s), wid = __builtin_amdgcn_readfirstlane(tid >> 6), lane = tid & 63, wr = wid >> 2, wc = wid & 3, fr = lane & 15, fq = lane >> 4;
    constexpr int nt = K / BK;
    unsigned voffA[2], voffB[2];
#pragma unroll
    for (int i = 0; i < 2; ++i) { int R, C; stage_rc(tid * 16 + i * 8192, R, C); const int Rb = Epi::PERM ? ((R & ~31) + perm32(R & 31)) : R;
        voffA[i] = (unsigned)(R * lda + C) * 2u; voffB[i] = (unsigned)(Rb * ldb + C) * 2u; }
    constexpr size_t kstepA = (size_t)KSA, kstepB = (size_t)KSB;
    constexpr size_t hstepA = (size_t)HALF * lda * 2, hstepB = (size_t)HALF * ldb * 2;
    constexpr size_t tstepA = (KSA == BK * 2) ? 2 * hstepA : (size_t)(K / BK) * KSA, tstepB = (KSB == BK * 2) ? 2 * hstepB : (size_t)(K / BK) * KSB;
    const unsigned ldsw = (unsigned)wid * 1024u;
    const int aoff = lds_byte(wr * 64 + fr, fq * 8), boff = lds_byte(wc * 32 + fr, fq * 8);
#define PG8_SA(b, h) (((b) * 2 + (h)) * HTB)
#define PG8_SB(b, h) ((4 + (b) * 2 + (h)) * HTB)
#define PG8_STAGE(bufoff, gbase, voff) do { _Pragma("unroll") for (int _i = 0; _i < 2; ++_i) \
        __builtin_amdgcn_global_load_lds((const GAS unsigned*)((const GAS char*)(gbase) + (voff)[_i]), (LAS unsigned*)(lds + (bufoff) + ldsw + _i * 8192), 16, 0, 0); } while (0)
#define PG8_LDA(dst, b, h) do { _Pragma("unroll") for (int m = 0; m < 4; ++m) _Pragma("unroll") for (int k = 0; k < 2; ++k) dst[m][k] = *(const LAS bf16x8*)(lds + PG8_SA(b, h) + aoff + m * 2048 + k * 1024); } while (0)
#define PG8_LDB(dst, b, h) do { _Pragma("unroll") for (int n = 0; n < 2; ++n) _Pragma("unroll") for (int k = 0; k < 2; ++k) dst[n][k] = *(const LAS bf16x8*)(lds + PG8_SB(b, h) + boff + n * 2048 + k * 1024); } while (0)
#define PG8_MMA(ai, bj, At, Bt) do { __builtin_amdgcn_s_setprio(1); _Pragma("unroll") for (int m = 0; m < 4; ++m) _Pragma("unroll") for (int n = 0; n < 2; ++n) _Pragma("unroll") for (int k = 0; k < 2; ++k) \
        acc[ai][bj][m][n] = __builtin_amdgcn_mfma_f32_16x16x32_bf16(Bt[n][k], At[m][k], acc[ai][bj][m][n], 0, 0, 0); __builtin_amdgcn_s_setprio(0); } while (0)
#define PG8_WAIT_V(n) asm volatile("s_waitcnt vmcnt(" #n ")" ::: "memory")
#define PG8_WAIT_L(n) asm volatile("s_waitcnt lgkmcnt(" #n ")" ::: "memory")
#define PG8_BAR __builtin_amdgcn_s_barrier()
#define PG8_SCHED __builtin_amdgcn_sched_barrier(0)
    Unit cur, nxt; int ui = 0;
    if (!S.next(0, cur)) return;
    f32x4 acc[2][2][4][2];
#pragma unroll
    for (int a = 0; a < 2; ++a)
#pragma unroll
        for (int b = 0; b < 2; ++b)
#pragma unroll
            for (int m = 0; m < 4; ++m)
#pragma unroll
                for (int n = 0; n < 2; ++n) acc[a][b][m][n] = (f32x4){0.f, 0.f, 0.f, 0.f};
    bf16x8 At[4][2], B0[2][2], B1[2][2];
    const GAS char* cA = (const GAS char*)g.A + (size_t)cur.pm * tstepA; const GAS char* cB = (const GAS char*)g.Bt + (size_t)cur.pn * tstepB;
    if constexpr (SP2) {
        PG8_STAGE(PG8_SB(0, 0), cB, voffB); PG8_STAGE(PG8_SB(0, 1), cB + hstepB, voffB); PG8_STAGE(PG8_SA(0, 0), cA, voffA); PG8_STAGE(PG8_SA(0, 1), cA + hstepA, voffA);
        if (wr == 1) PG8_BAR;
        PG8_WAIT_V(2); PG8_BAR;
        PG8_STAGE(PG8_SB(1, 0), cB + kstepB, voffB); PG8_STAGE(PG8_SA(1, 0), cA + kstepA, voffA); PG8_STAGE(PG8_SB(1, 1), cB + hstepB + kstepB, voffB);
        PG8_WAIT_V(6); PG8_BAR;
    } else {
        PG8_STAGE(PG8_SB(0, 0), cB, voffB); PG8_STAGE(PG8_SA(0, 0), cA, voffA); PG8_STAGE(PG8_SB(0, 1), cB + hstepB, voffB); PG8_STAGE(PG8_SA(0, 1), cA + hstepA, voffA);
        if (wr == 1) PG8_BAR;
        PG8_WAIT_V(4); PG8_BAR;
        PG8_STAGE(PG8_SB(1, 0), cB + kstepB, voffB); PG8_STAGE(PG8_SA(1, 0), cA + kstepA, voffA); PG8_STAGE(PG8_SB(1, 1), cB + hstepB + kstepB, voffB);
        PG8_WAIT_V(6); PG8_BAR;
    }
    for (;;) {
        const bool has_next = S.next(ui + 1, nxt);
        const GAS char* nA = has_next ? (const GAS char*)g.A + (size_t)nxt.pm * tstepA : cA; const GAS char* nB = has_next ? (const GAS char*)g.Bt + (size_t)nxt.pn * tstepB : cB;
        constexpr int PFT = (TJ > 0) ? 8 : ((nt / 2) & ~1);
#pragma unroll 1
        for (int seg = 0; seg < (Epi::PF ? 2 : 1); ++seg) {
        const int tb = (Epi::PF && seg == 1) ? PFT : 0, te = (Epi::PF && seg == 0) ? PFT : nt;
        if constexpr (Epi::PF) { if (seg == 1) E.prefetch(cur, lds, wave_s); }
        for (int t = tb; t < te; t += 2) {
            const bool last = (t == nt - 2);
            const size_t j1 = (TJ > 0 && t >= TJ) ? JUMPA : 0, j2 = (TJ > 0 && t + 2 >= TJ) ? JUMPA : 0;
            const GAS char* a1 = cA + (size_t)(t + 1) * kstepA + j1;
            const GAS char* a2 = last ? nA : cA + (size_t)(t + 2) * kstepA + j2; const GAS char* b2 = last ? nB : cB + (size_t)(t + 2) * kstepB;
            const GAS char* a3 = a2 + kstepA; const GAS char* b3 = b2 + kstepB;
            if constexpr (TJ > 0) { if (t == TJ) E.mid(acc, cur, wr, wc, fr, fq); }
            asm volatile("" : "+s"(a1), "+s"(a2), "+s"(b2), "+s"(a3), "+s"(b3), "+v"(voffA[0]), "+v"(voffA[1]), "+v"(voffB[0]), "+v"(voffB[1]));
            if constexpr (SP2) {
            PG8_LDB(B0, 0, 0); PG8_LDB(B1, 0, 1); PG8_SCHED; PG8_LDA(At, 0, 0); PG8_STAGE(PG8_SA(1, 1), a1 + hstepA, voffA);
            PG8_WAIT_V(8); PG8_WAIT_L(0); PG8_BAR; PG8_MMA(0, 0, At, B0); PG8_MMA(0, 1, At, B1); PG8_BAR; PG8_SCHED;
            PG8_LDA(At, 0, 1); PG8_STAGE(PG8_SB(0, 0), b2, voffB); PG8_STAGE(PG8_SB(0, 1), b2 + hstepB, voffB); PG8_STAGE(PG8_SA(0, 0), a2, voffA);
            PG8_WAIT_V(8); PG8_WAIT_L(0); PG8_BAR; PG8_MMA(1, 0, At, B0); PG8_MMA(1, 1, At, B1); PG8_BAR; PG8_SCHED;
            PG8_LDB(B0, 1, 0); PG8_LDB(B1, 1, 1); PG8_SCHED; PG8_LDA(At, 1, 0); PG8_STAGE(PG8_SA(0, 1), a2 + hstepA, voffA);
            PG8_WAIT_V(8); PG8_WAIT_L(0); PG8_BAR; PG8_MMA(0, 0, At, B0); PG8_MMA(0, 1, At, B1); PG8_BAR; PG8_SCHED;
            PG8_LDA(At, 1, 1); PG8_STAGE(PG8_SB(1, 0), b3, voffB); PG8_STAGE(PG8_SB(1, 1), b3 + hstepB, voffB); PG8_STAGE(PG8_SA(1, 0), a3, voffA);
            PG8_WAIT_V(8); PG8_WAIT_L(0); PG8_BAR; PG8_MMA(1, 0, At, B0); PG8_MMA(1, 1, At, B1); PG8_BAR; PG8_SCHED;
            } else {
            PG8_LDB(B0, 0, 0); PG8_SCHED; PG8_LDA(At, 0, 0); PG8_STAGE(PG8_SA(1, 1), a1 + hstepA, voffA);
            PG8_WAIT_L(8); PG8_BAR; PG8_WAIT_L(0); PG8_MMA(0, 0, At, B0); PG8_BAR; PG8_SCHED;
            PG8_LDB(B1, 0, 1); PG8_STAGE(PG8_SB(0, 0), b2, voffB);
            PG8_BAR; PG8_WAIT_L(0); PG8_MMA(0, 1, At, B1); PG8_BAR;
            PG8_LDA(At, 0, 1); PG8_STAGE(PG8_SA(0, 0), a2, voffA);
            PG8_BAR; PG8_WAIT_L(0); PG8_MMA(1, 0, At, B0); PG8_BAR; PG8_SCHED;
            PG8_STAGE(PG8_SB(0, 1), b2 + hstepB, voffB);
            PG8_WAIT_V(6); PG8_BAR; PG8_MMA(1, 1, At, B1); PG8_BAR;
            PG8_LDB(B0, 1, 0); PG8_SCHED; PG8_LDA(At, 1, 0); PG8_STAGE(PG8_SA(0, 1), a2 + hstepA, voffA);
            PG8_WAIT_L(8); PG8_BAR; PG8_WAIT_L(0); PG8_MMA(0, 0, At, B0); PG8_BAR; PG8_SCHED;
            PG8_LDB(B1, 1, 1); PG8_STAGE(PG8_SB(1, 0), b3, voffB);
            PG8_BAR; PG8_WAIT_L(0); PG8_MMA(0, 1, At, B1); PG8_BAR;
            PG8_LDA(At, 1, 1); PG8_STAGE(PG8_SA(1, 0), a3, voffA);
            PG8_BAR; PG8_WAIT_L(0); PG8_MMA(1, 0, At, B0); PG8_BAR; PG8_SCHED;
            PG8_STAGE(PG8_SB(1, 1), b3 + hstepB, voffB);
            PG8_WAIT_V(6); PG8_BAR; PG8_MMA(1, 1, At, B1); PG8_BAR;
            }
        }
        }
        if constexpr (ALIGN_EPI) { if (wr == 0) PG8_BAR; }
        E(acc, cur, wr, wc, fr, fq);
        if (!has_next) break;
#pragma unroll
        for (int a = 0; a < 2; ++a)
#pragma unroll
            for (int b = 0; b < 2; ++b)
#pragma unroll
                for (int m = 0; m < 4; ++m)
#pragma unroll
                    for (int n = 0; n < 2; ++n) acc[a][b][m][n] = (f32x4){0.f, 0.f, 0.f, 0.f};
        cur = nxt; cA = nA; cB = nB; ++ui;
        if constexpr (ALIGN_EPI) { if (wr == 1) PG8_BAR; }
    }
    PG8_WAIT_V(0);
    if constexpr (!ALIGN_EPI) { if (wr == 0) PG8_BAR; }
    PG8_BAR;
#undef PG8_SA
#undef PG8_SB
#undef PG8_STAGE
#undef PG8_LDA
#undef PG8_LDB
#undef PG8_MMA
#undef PG8_WAIT_V
#undef PG8_WAIT_L
#undef PG8_BAR
#undef PG8_SCHED
}

struct EpiNone {
    static constexpr bool PERM = true; static constexpr bool PF = false;
    __device__ __forceinline__ void operator()(const f32x4 (&acc)[2][2][4][2], const Unit&, int, int, int, int) const {
#pragma unroll
        for (int a = 0; a < 2; ++a)
#pragma unroll
            for (int b = 0; b < 2; ++b)
#pragma unroll
                for (int m = 0; m < 4; ++m)
#pragma unroll
                    for (int n = 0; n < 2; ++n) asm volatile("" :: "v"(acc[a][b][m][n]));
    }
};
struct EpiSwiglu {
    static constexpr bool PERM = true; static constexpr bool PF = false;
    gbf16* O;
    __device__ __forceinline__ void operator()(const f32x4 (&acc)[2][2][4][2], const Unit& u, int wr, int wc, int fr, int fq) const {
        const int row0 = u.pm * BM + wr * 64 + fr, col0 = u.pn * HALF + wc * 32 + 8 * fq;
#pragma unroll
        for (int ai = 0; ai < 2; ++ai)
#pragma unroll
            for (int m = 0; m < 4; ++m) {
                gbf16* rowp = O + (size_t)(row0 + ai * HALF + m * 16) * DFF + col0;
                const f32x4 g0 = acc[ai][0][m][0], g1 = acc[ai][0][m][1], u0 = acc[ai][1][m][0], u1 = acc[ai][1][m][1];
                u32x4 w;
                w.x = cvt_pk_bf16(silu_f(g0[0]) * u0[0], silu_f(g0[1]) * u0[1]); w.y = cvt_pk_bf16(silu_f(g0[2]) * u0[2], silu_f(g0[3]) * u0[3]);
                w.z = cvt_pk_bf16(silu_f(g1[0]) * u1[0], silu_f(g1[1]) * u1[1]); w.w = cvt_pk_bf16(silu_f(g1[2]) * u1[2], silu_f(g1[3]) * u1[3]);
                *(GAS u32x4*)rowp = w;
            }
    }
};
template <int LNF> struct EpiResid {
    static constexpr bool PERM = true; static constexpr int ln = LNF; static constexpr bool PF = (LNF != 0);
    __device__ __forceinline__ void prefetch(const Unit& u, LAS unsigned char* lds, int wave_s) const {
        GAS unsigned short* Yp = Y; asm volatile("" : "+s"(Yp));
        const int tid = make_tid(wave_s), wid = __builtin_amdgcn_readfirstlane(tid >> 6);
        const GAS char* a = (const GAS char*)(Yp + (size_t)(u.pm * BM + (tid >> 1)) * D + u.pn * BM) + (tid & 1) * 256;
        LAS unsigned* dst = (LAS unsigned*)(lds + 131072 + wid * 256);
        __builtin_amdgcn_global_load_lds((const GAS unsigned*)a, dst, 4, 0, 0);
        __builtin_amdgcn_global_load_lds((const GAS unsigned*)(a + 128), dst, 4, 0, 0);
    }
    const gf32* xsrc_p; const gf32* xsrc_s;
    GAS unsigned short* Y;
    const gf32* gate;
    const gf32* rs; const gf32* lng; const gf32* lnb;
    float wgt;
    __device__ __forceinline__ void operator()(const f32x4 (&acc)[2][2][4][2], const Unit& u, int wr, int wc, int fr, int fq) const {
        const int rowt = u.pm * BM, row0 = rowt + wr * 64 + fr, col0 = u.pn * BM + wc * 32 + 8 * fq;
        const int b = batch_of(rowt);
        const gf32* gp = gate + (size_t)b * NMOD * D + col0;
#pragma unroll
        for (int ai = 0; ai < 2; ++ai) {
            f32x2 st[4];
#pragma unroll
            for (int m = 0; m < 4; ++m) { st[m] = (f32x2){0.f, 1.f}; if (ln) st[m] = *(const GAS f32x2*)(rs + 2 * (size_t)(row0 + ai * HALF + m * 16)); }
#pragma unroll
            for (int bj = 0; bj < 2; ++bj) {
                const int co = bj * HALF;
                u32x4 yw[4]; u32x2 pk[4];
                if (ln) {
#pragma unroll
                    for (int m = 0; m < 4; ++m) yw[m] = *(const GAS u32x4*)(Y + (size_t)(row0 + ai * HALF + m * 16) * D + col0 + co);
                }
#pragma unroll
                for (int n = 0; n < 2; ++n) {
                    const f32x4 gv = *(const GAS f32x4*)(gp + co + 4 * n) * wgt;
                    f32x4 ga = (f32x4){DN_ALPHA, DN_ALPHA, DN_ALPHA, DN_ALPHA}, ba = (f32x4){0.f, 0.f, 0.f, 0.f};
                    if (ln) { ga = *(const GAS f32x4*)(lng + col0 + co + 4 * n) * DN_ALPHA; ba = *(const GAS f32x4*)(lnb + col0 + co + 4 * n) * DN_ALPHA; }
                    f32x4 xv[4];
                    if (ln) {
#pragma unroll
                        for (int m = 0; m < 4; ++m) { const unsigned w0 = n ? yw[m].z : yw[m].x, w1 = n ? yw[m].w : yw[m].y; xv[m] = (f32x4){f16lo(w0), f16hi(w0), f16lo(w1), f16hi(w1)}; }
                    } else {
                        const gf32* xs = (rowt < MP) ? xsrc_p + (size_t)row0 * D : xsrc_s + (size_t)(row0 - MP) * D;
#pragma unroll
                        for (int m = 0; m < 4; ++m) xv[m] = *(const GAS f32x4*)(xs + (size_t)(ai * HALF + m * 16) * D + col0 + co + 4 * n);
                    }
#pragma unroll
                    for (int m = 0; m < 4; ++m) {
                        const f32x4 o = (xv[m] - st[m].x) * st[m].y * ga + ba + gv * acc[ai][bj][m][n];
                        const u32x2 p2 = {pk_f16(o[0], o[1]), pk_f16(o[2], o[3])};
                        if (n == 0) pk[m] = p2;
                        else *(GAS u32x4*)(Y + (size_t)(row0 + ai * HALF + m * 16) * D + col0 + co) = (u32x4){pk[m].x, pk[m].y, p2.x, p2.y};
                    }
                }
            }
        }
    }
};
struct EpiMix {
    static constexpr bool PERM = true; static constexpr bool PF = false;
    gbf16* Z; const gf32* cosT; const gf32* sinT; gf32* SP;
    __device__ __forceinline__ void operator()(const f32x4 (&acc)[2][2][4][2], const Unit& u, int wr, int wc, int fr, int fq) const {
        const int pn = u.pn, row0 = u.pm * BM + wr * 64 + fr;
        const int reg = pn < 40 ? (pn >> 3) : 5 + ((pn - 40) >> 1);
        const int ld = pn < 40 ? D : KVW;
        const int colt = pn < 40 ? (pn & 7) * BM : ((pn - 40) & 1) * BM;
        const size_t roff = pn < 40 ? (size_t)reg * ((size_t)M * D) : ZB_K + (size_t)(reg - 5) * ((size_t)M * KVW);
        gbf16* base = Z + roff + colt + wc * 32 + 8 * fq;
        const int kind = (reg == 0 || reg == 5) ? 0 : (reg <= 2 ? 1 : (reg <= 4 ? 2 : 3));
        if (kind == 0) {
#pragma unroll
            for (int ai = 0; ai < 2; ++ai) {
                f32x4 c4[4], s4[4];
#pragma unroll
                for (int m = 0; m < 4; ++m) { const int pos = pos_of(row0 + ai * HALF + m * 16);
                    c4[m] = *(const GAS f32x4*)(cosT + (size_t)pos * 64 + wc * 16 + fq * 4); s4[m] = *(const GAS f32x4*)(sinT + (size_t)pos * 64 + wc * 16 + fq * 4); }
#pragma unroll
                for (int m = 0; m < 4; ++m) { gbf16* rowp = base + (size_t)(row0 + ai * HALF + m * 16) * ld;
#pragma unroll
                    for (int bj = 0; bj < 2; ++bj) { const f32x4 x1 = acc[ai][bj][m][0], x2 = acc[ai][bj][m][1];
                        const f32x4 o1 = x1 * c4[m] - x2 * s4[m], o2 = x2 * c4[m] + x1 * s4[m];
                        u32x4 w; w.x = cvt_pk_bf16(o1[0], o1[1]); w.y = cvt_pk_bf16(o1[2], o1[3]); w.z = cvt_pk_bf16(o2[0], o2[1]); w.w = cvt_pk_bf16(o2[2], o2[3]);
                        *(GAS u32x4*)(rowp + bj * HALF) = w; } }
            }
        } else {
#pragma unroll
            for (int ai = 0; ai < 2; ++ai)
#pragma unroll
                for (int m = 0; m < 4; ++m) { gbf16* rowp = base + (size_t)(row0 + ai * HALF + m * 16) * ld;
                    float rs_ = 0.f, rq_ = 0.f;
#pragma unroll
                    for (int bj = 0; bj < 2; ++bj) { f32x4 v0 = acc[ai][bj][m][0], v1 = acc[ai][bj][m][1];
                        if (kind == 1) {
#pragma unroll
                            for (int j = 0; j < 4; ++j) { v0[j] = gelu_tanh_f(v0[j]); v1[j] = gelu_tanh_f(v1[j]); }
                            if (reg == 2) {
#pragma unroll
                                for (int j = 0; j < 4; ++j) { rs_ += v0[j] + v1[j]; rq_ += v0[j] * v0[j] + v1[j] * v1[j]; } }
                        } else if (kind == 2) {
#pragma unroll
                            for (int j = 0; j < 4; ++j) { v0[j] = sigmoid_f(v0[j]); v1[j] = sigmoid_f(v1[j]); }
                        }
                        u32x4 w; w.x = cvt_pk_bf16(v0[0], v0[1]); w.y = cvt_pk_bf16(v0[2], v0[3]); w.z = cvt_pk_bf16(v1[0], v1[1]); w.w = cvt_pk_bf16(v1[2], v1[3]);
                        *(GAS u32x4*)(rowp + bj * HALF) = w; }
                    if (reg == 2) {
                        rs_ += swz_xor<16>(rs_); rq_ += swz_xor<16>(rq_);
                        { auto r1 = __builtin_amdgcn_permlane32_swap(__float_as_uint(rs_), __float_as_uint(rs_), false, false); rs_ = __uint_as_float(r1[0]) + __uint_as_float(r1[1]);
                          auto r2 = __builtin_amdgcn_permlane32_swap(__float_as_uint(rq_), __float_as_uint(rq_), false, false); rq_ = __uint_as_float(r2[0]) + __uint_as_float(r2[1]); }
                        if (fq == 0) *(GAS f32x2*)(SP + ((size_t)(row0 + ai * HALF + m * 16) * 32 + (pn - 16) * 4 + wc) * 2) = (f32x2){rs_, rq_}; } }
        }
    }
};
struct EpiBranchF {
    static constexpr bool PERM = true; static constexpr bool PF = true;
    __device__ __forceinline__ void prefetch(const Unit& u, LAS unsigned char* lds, int wave_s) const {
        const gbf16* Ga = this->Ga; const gbf16* Gb = this->Gb; asm volatile("" : "+s"(Ga), "+s"(Gb));
        const int tid = make_tid(wave_s), wid = __builtin_amdgcn_readfirstlane(tid >> 6);
        const size_t o = ((size_t)(u.pm * BM + (tid >> 1)) * D + u.pn * BM) * 2 + (tid & 1) * 256;
        LAS unsigned* dst = (LAS unsigned*)(lds + 131072 + wid * 256);
        __builtin_amdgcn_global_load_lds((const GAS unsigned*)((const GAS char*)Ga + o), dst, 4, 0, 0);
        __builtin_amdgcn_global_load_lds((const GAS unsigned*)((const GAS char*)Ga + o + 128), dst, 4, 0, 0);
        __builtin_amdgcn_global_load_lds((const GAS unsigned*)((const GAS char*)Gb + o), dst, 4, 0, 0);
        __builtin_amdgcn_global_load_lds((const GAS unsigned*)((const GAS char*)Gb + o + 128), dst, 4, 0, 0);
    }
    gbf16* O; const gbf16* Ga; const gbf16* Gb;
    __device__ __forceinline__ void mid(f32x4 (&acc)[2][2][4][2], const Unit& u, int wr, int wc, int fr, int fq) const {
        const gbf16* Ga = this->Ga; const gbf16* Gb = this->Gb; int rowl = wr * 64 + fr;
        asm volatile("" : "+s"(Ga), "+s"(Gb), "+v"(rowl));
        const int row0 = u.pm * BM + rowl, col0 = u.pn * BM + wc * 32 + 8 * fq;
#pragma unroll
        for (int ai = 0; ai < 2; ++ai)
#pragma unroll
            for (int mp = 0; mp < 2; ++mp) {
                u32x4 ga[2][2], gb[2][2];
#pragma unroll
                for (int mm = 0; mm < 2; ++mm)
#pragma unroll
                    for (int bj = 0; bj < 2; ++bj) { const size_t o = (size_t)(row0 + ai * HALF + (2 * mp + mm) * 16) * D + col0 + bj * HALF; ga[mm][bj] = *(const GAS u32x4*)(Ga + o); gb[mm][bj] = *(const GAS u32x4*)(Gb + o); }
#pragma unroll
                for (int mm = 0; mm < 2; ++mm)
#pragma unroll
                    for (int bj = 0; bj < 2; ++bj) { const u32x4 a4 = ga[mm][bj], b4 = gb[mm][bj]; const int m = 2 * mp + mm;
                        const float sa[8] = { bflo(a4.x), bfhi(a4.x), bflo(a4.y), bfhi(a4.y), bflo(a4.z), bfhi(a4.z), bflo(a4.w), bfhi(a4.w) };
                        const float sb[8] = { bflo(b4.x), bfhi(b4.x), bflo(b4.y), bfhi(b4.y), bflo(b4.z), bfhi(b4.z), bflo(b4.w), bfhi(b4.w) };
#pragma unroll
                        for (int j = 0; j < 4; ++j) { acc[ai][bj][m][0][j] *= sa[j] * fast_rcp(fmaxf(sb[j], 8.673617379884035e-19f)); acc[ai][bj][m][1][j] *= sa[4 + j] * fast_rcp(fmaxf(sb[4 + j], 8.673617379884035e-19f)); } }
            }
    }
    __device__ __forceinline__ void operator()(const f32x4 (&acc)[2][2][4][2], const Unit& u, int wr, int wc, int fr, int fq) const {
        const int row0 = u.pm * BM + wr * 64 + fr, col0 = u.pn * BM + wc * 32 + 8 * fq;
#pragma unroll
        for (int ai = 0; ai < 2; ++ai) {
            u32x4 gb[4][2];
#pragma unroll
            for (int m = 0; m < 4; ++m)
#pragma unroll
                for (int bj = 0; bj < 2; ++bj) gb[m][bj] = *(const GAS u32x4*)(Gb + (size_t)(row0 + ai * HALF + m * 16) * D + col0 + bj * HALF);
#pragma unroll
            for (int m = 0; m < 4; ++m)
#pragma unroll
                for (int bj = 0; bj < 2; ++bj) { const u32x4 b4 = gb[m][bj]; const f32x4 v0 = acc[ai][bj][m][0], v1 = acc[ai][bj][m][1];
                    const float sb[8] = { bflo(b4.x), bfhi(b4.x), bflo(b4.y), bfhi(b4.y), bflo(b4.z), bfhi(b4.z), bflo(b4.w), bfhi(b4.w) };
                    float r[8];
#pragma unroll
                    for (int j = 0; j < 4; ++j) { r[j] = v0[j] * fmaxf(sb[j], 8.673617379884035e-19f); r[4 + j] = v1[j] * fmaxf(sb[4 + j], 8.673617379884035e-19f); }
                    u32x4 w; w.x = cvt_pk_bf16(r[0], r[1]); w.y = cvt_pk_bf16(r[2], r[3]); w.z = cvt_pk_bf16(r[4], r[5]); w.w = cvt_pk_bf16(r[6], r[7]);
                    *(GAS u32x4*)(O + (size_t)(row0 + ai * HALF + m * 16) * D + col0 + bj * HALF) = w; }
        }
    }
};
}

namespace att {
constexpr int KVBLK = 64, NW = 8, QBLK = 32;
constexpr float SCALE = 0.088388347648318440f;
constexpr float THR = 8.f;
#ifndef ATT_SDEPTH
#define ATT_SDEPTH 1
#endif
constexpr int SDEPTH = ATT_SDEPTH;
constexpr int SHM_V = KVBLK * HD * 2, SHM_K = KVBLK * HD * 2;
#define KSWZ(row, colB) ((row) * 256 + ((colB) ^ (((row) & 7) << 4)))
#define SBAR() __builtin_amdgcn_sched_barrier(0)
__device__ __forceinline__ int crow(int r, int hi) { return (r & 3) + 8 * (r >> 2) + 4 * hi; }
__device__ __forceinline__ void partialSM(f32x16& p0, f32x16& p1, float& m_reg, float& mn, float& alpha) {
  constexpr float C = SCALE * 1.4426950408889634f;
  float pmax = p0[0];
#pragma unroll
  for (int r = 1; r < 16; ++r) pmax = fmaxf(pmax, p0[r]);
#pragma unroll
  for (int r = 0; r < 16; ++r) pmax = fmaxf(pmax, p1[r]);
  { auto rr = __builtin_amdgcn_permlane32_swap(__float_as_uint(pmax), __float_as_uint(pmax), false, false);
    pmax = fmaxf(__uint_as_float(rr[0]), __uint_as_float(rr[1])); }
  if (__builtin_expect(__all(pmax - m_reg <= THR / SCALE), 1)) { mn = m_reg; alpha = 1.f; }
  else { mn = fmaxf(m_reg, pmax); alpha = __builtin_amdgcn_exp2f((m_reg - mn) * C); m_reg = mn; }
  float mnC = -mn * C;
#pragma unroll
  for (int r = 0; r < 16; ++r) p0[r] = fmaf(p0[r], C, mnC);
#pragma unroll
  for (int r = 0; r < 16; ++r) p1[r] = fmaf(p1[r], C, mnC);
#pragma unroll
  for (int r = 0; r < 16; ++r) p0[r] = __builtin_amdgcn_exp2f(p0[r]);
}
__device__ __forceinline__ void finishSM(f32x16& p0, f32x16& p1, float alpha, float& l_reg, bf16x8& pa0, bf16x8& pa1, bf16x8& pa2, bf16x8& pa3) {
#pragma unroll
  for (int r = 0; r < 16; ++r) p1[r] = __builtin_amdgcn_exp2f(p1[r]);
  float ps = 0;
#pragma unroll
  for (int r = 0; r < 16; ++r) ps += p0[r];
#pragma unroll
  for (int r = 0; r < 16; ++r) ps += p1[r];
  { auto rr = __builtin_amdgcn_permlane32_swap(__float_as_uint(ps), __float_as_uint(ps), false, false);
    ps = __uint_as_float(rr[0]) + __uint_as_float(rr[1]); }
  l_reg = l_reg * alpha + ps;
#define PK4(P, BASE, OUT) do { unsigned a0 = cvt_pk_bf16(P[BASE + 0], P[BASE + 1]), a1 = cvt_pk_bf16(P[BASE + 2], P[BASE + 3]);   \
    unsigned b0 = cvt_pk_bf16(P[BASE + 4], P[BASE + 5]), b1 = cvt_pk_bf16(P[BASE + 6], P[BASE + 7]);                              \
    auto r0 = __builtin_amdgcn_permlane32_swap(a0, b0, false, false); auto r1 = __builtin_amdgcn_permlane32_swap(a1, b1, false, false); \
    u32x4 w = {r0[0], r1[0], r0[1], r1[1]}; OUT = *reinterpret_cast<bf16x8*>(&w); } while (0)
  PK4(p0, 0, pa0); PK4(p0, 8, pa1); PK4(p1, 0, pa2); PK4(p1, 8, pa3);
#undef PK4
}
__device__ __forceinline__ void qkt(f32x16& p0, f32x16& p1, const LAS char* Ks, const bf16x8* qr, int r32, int hi) {
  p0 = f32x16{}; p1 = f32x16{};
#pragma unroll
  for (int d0 = 0; d0 < 8; ++d0) { int cb = (d0 * 16 + hi * 8) * 2;
    bf16x8 b0 = *(const LAS bf16x8*)(Ks + KSWZ(r32, cb));
    bf16x8 b1 = *(const LAS bf16x8*)(Ks + KSWZ(32 + r32, cb));
    p0 = __builtin_amdgcn_mfma_f32_32x32x16_bf16(b0, qr[d0], p0, 0, 0, 0);
    p1 = __builtin_amdgcn_mfma_f32_32x32x16_bf16(b1, qr[d0], p1, 0, 0, 0); }
}
__device__ __forceinline__ void band_mask(f32x16& p0, f32x16& p1, int ktp, int q, int hi) {
  const float ninf = -__builtin_inff();
  if (ktp < 2) { const int kb = 64 * ktp - 128, lim = q - 128;
#pragma unroll
    for (int r = 0; r < 16; ++r) { const int k = kb + crow(r, hi); if (k < lim) p0[r] = ninf; if (k + 32 < lim) p1[r] = ninf; }
  } else if (ktp >= 4) { const int kb = 64 * ktp - 128, lim = q + 128;
#pragma unroll
    for (int r = 0; r < 16; ++r) { const int k = kb + crow(r, hi); if (k > lim) p0[r] = ninf; if (k + 32 > lim) p1[r] = ninf; }
  }
}
__device__ __forceinline__ int v_st(int k, int c) { const int kk = (k & ~0xC) | ((k & 4) << 1) | ((k & 8) >> 1); return ((kk >> 3) * 4 + (c >> 5)) * 512 + ((kk & 7) * 32 + (c & 31)) * 2; }
__device__ __forceinline__ int v_rd_base(int lane) { return ((lane & 3) << 3) | (((lane >> 2) & 3) << 6) | (((lane >> 4) & 1) << 5) | (((lane >> 5) & 1) << 8); }
constexpr int v_rd_off(int d0, int ks, int half) { return d0 * 512 + ks * 4096 + half * 2048; }
template <int OFF> __device__ __forceinline__ s16x4 tr_read(int vb) {
  s16x4 r; asm volatile("ds_read_b64_tr_b16 %0, %1 offset:%2" : "=&v"(r) : "v"(vb), "i"(OFF) : "memory"); return r;
}
template <int D0> __device__ __forceinline__ void pv_one(f32x16& od, int vb, bf16x8 pa0, bf16x8 pa1, bf16x8 pa2, bf16x8 pa3) {
  const s16x4 l0 = tr_read<v_rd_off(D0, 0, 0)>(vb), h0 = tr_read<v_rd_off(D0, 0, 1)>(vb), l1 = tr_read<v_rd_off(D0, 1, 0)>(vb), h1 = tr_read<v_rd_off(D0, 1, 1)>(vb);
  const s16x4 l2 = tr_read<v_rd_off(D0, 2, 0)>(vb), h2 = tr_read<v_rd_off(D0, 2, 1)>(vb), l3 = tr_read<v_rd_off(D0, 3, 0)>(vb), h3 = tr_read<v_rd_off(D0, 3, 1)>(vb);
  asm volatile("s_waitcnt lgkmcnt(0)" ::: "memory"); SBAR();
#define PK(L, H) (bf16x8){L[0], L[1], L[2], L[3], H[0], H[1], H[2], H[3]}
  od = __builtin_amdgcn_mfma_f32_32x32x16_bf16(pa0, PK(l0, h0), od, 0, 0, 0);
  od = __builtin_amdgcn_mfma_f32_32x32x16_bf16(pa1, PK(l1, h1), od, 0, 0, 0);
  od = __builtin_amdgcn_mfma_f32_32x32x16_bf16(pa2, PK(l2, h2), od, 0, 0, 0);
  od = __builtin_amdgcn_mfma_f32_32x32x16_bf16(pa3, PK(l3, h3), od, 0, 0, 0);
#undef PK
}
__device__ __forceinline__ void pv_d0(f32x16* o, int vb, bf16x8 pa0, bf16x8 pa1, bf16x8 pa2, bf16x8 pa3) {
  pv_one<0>(o[0], vb, pa0, pa1, pa2, pa3); pv_one<1>(o[1], vb, pa0, pa1, pa2, pa3); pv_one<2>(o[2], vb, pa0, pa1, pa2, pa3); pv_one<3>(o[3], vb, pa0, pa1, pa2, pa3);
}

__device__ __forceinline__ void attn_unit(gbf16* Zq, gbf16* Oq, const gbf16* Zk, const gbf16* Zv, int seq_row0, int nb, int nblk, int g, int hp, const gf32* sink16, LAS char* lds, int wave_s) {
  const int tid = make_tid(wave_s), wid = __builtin_amdgcn_readfirstlane(tid >> 6), lane = tid & 63, r32 = lane & 31, hi = lane >> 5;
  LAS char* V_lds = lds; LAS char* K_lds = lds + 2 * SHM_V;
  LAS float* ws = (LAS float*)(lds + 2 * SHM_V + 2 * SHM_K) + wid * 64; LAS float* li_l = ws; LAS float* al_l = ws + 32;
  float m_reg = -1e30f, l_reg = 0; f32x16 o[4] = {}; bf16x8 qr[8];
  const int qsub = (wid & 3) ^ ((wid >> 2) << 1);
  const int hq = 4 * g + 2 * hp + (wid >> 2), qrel0 = 32 * qsub, qi = qrel0 + r32;
#define SKIPT(t) (((t) == 0 && qsub >= 2) || ((t) == 5 && qsub < 2))
#define MASKT(t) (((t) == 0 && qsub < 2) || ((t) == 1 && qsub >= 2) || ((t) == 4 && qsub < 2) || ((t) == 5 && qsub >= 2))
  const int blk_row0 = seq_row0 + 128 * nb;
  const gbf16* Qw = Zq + (size_t)(blk_row0 + qi) * D + hq * HD + hi * 8;
#pragma unroll
  for (int d0 = 0; d0 < 8; ++d0) qr[d0] = *(const GAS bf16x8*)(Qw + d0 * 16);
  const int kt_lo = (nb == 0) ? 2 : 0, kt_hi = (nb == nblk - 1) ? 4 : 6, NT = kt_hi - kt_lo;
  const gbf16* Kh = Zk + (size_t)(blk_row0 - 128 + 64 * kt_lo) * KVW + g * HD;
  const gbf16* Vh = Zv + (size_t)(blk_row0 - 128 + 64 * kt_lo) * KVW + g * HD;
  const int sr = tid >> 4, sc = (tid & 15) * 8, vst0 = v_st(sr, sc), vst1 = v_st(32 + sr, sc);
  const int vb0 = (int)(uintptr_t)V_lds + v_rd_base(lane);
  struct { bf16x8 vs0, vs1, ks0, ks1; } sr_[SDEPTH];
#define SLOAD(i, k0) do { sr_[i].vs0 = *(const GAS bf16x8*)(&Vh[(size_t)((k0) + sr) * KVW + sc]); sr_[i].vs1 = *(const GAS bf16x8*)(&Vh[(size_t)((k0) + 32 + sr) * KVW + sc]); \
    sr_[i].ks0 = *(const GAS bf16x8*)(&Kh[(size_t)((k0) + sr) * KVW + sc]); sr_[i].ks1 = *(const GAS bf16x8*)(&Kh[(size_t)((k0) + 32 + sr) * KVW + sc]); } while (0)
#define SWRITE(b, i) do { *(LAS bf16x8*)(V_lds + (b) * SHM_V + vst0) = sr_[i].vs0;          \
    *(LAS bf16x8*)(V_lds + (b) * SHM_V + vst1) = sr_[i].vs1; int kc = sc * 2;               \
    *(LAS bf16x8*)(K_lds + (b) * SHM_K + KSWZ(sr, kc)) = sr_[i].ks0;                       \
    *(LAS bf16x8*)(K_lds + (b) * SHM_K + KSWZ(32 + sr, kc)) = sr_[i].ks1; } while (0)
#define SWAIT() do { if constexpr (SDEPTH == 2) asm volatile("s_waitcnt vmcnt(4)" ::: "memory"); else asm volatile("s_waitcnt vmcnt(0)" ::: "memory"); } while (0)
#define RESC(a) do { if (__any((a) < 1.f)) { if (hi == 0) al_l[r32] = (a); asm volatile("s_waitcnt lgkmcnt(0)" ::: "memory"); \
    _Pragma("unroll") for (int d = 0; d < 4; ++d) _Pragma("unroll") for (int r = 0; r < 16; ++r) o[d][r] *= al_l[crow(r, hi)]; } } while (0)
  f32x16 pA0, pA1, pB0, pB1; float mnA, mnB, alA, alB; bf16x8 pa0, pa1, pa2, pa3;
  constexpr int SE = 0, SO = SDEPTH - 1;
  bool sA = SKIPT(kt_lo), sB = false;
  SLOAD(SE, 0); asm volatile("s_waitcnt vmcnt(0)" ::: "memory"); SWRITE(0, SE); __syncthreads();
  if (!sA) { qkt(pA0, pA1, K_lds, qr, r32, hi); if (MASKT(kt_lo)) band_mask(pA0, pA1, kt_lo, qi, hi); partialSM(pA0, pA1, m_reg, mnA, alA); } else alA = 1.f;
  SLOAD(SO, KVBLK); if constexpr (SDEPTH == 2) { if (2 < NT) SLOAD(SE, 2 * KVBLK); }
  SWAIT(); SWRITE(1, SO); __syncthreads();
  for (int j = 1; j + 1 < NT; j += 2) {
    sB = SKIPT(kt_lo + j);
    SBAR(); if (!sB) { qkt(pB0, pB1, K_lds + SHM_K, qr, r32, hi); if (MASKT(kt_lo + j)) band_mask(pB0, pB1, kt_lo + j, qi, hi); }
    if (!sA) finishSM(pA0, pA1, alA, l_reg, pa0, pa1, pa2, pa3); SBAR();
    SLOAD(SO, (j + SDEPTH) * KVBLK); SBAR();
    if (!sA) pv_d0(o, vb0, pa0, pa1, pa2, pa3);
    if (!sB) partialSM(pB0, pB1, m_reg, mnB, alB); else alB = 1.f;
    __syncthreads(); SWAIT(); SWRITE(0, SE);
    RESC(alB); __syncthreads();
    sA = SKIPT(kt_lo + j + 1);
    SBAR(); if (!sA) { qkt(pA0, pA1, K_lds, qr, r32, hi); if (MASKT(kt_lo + j + 1)) band_mask(pA0, pA1, kt_lo + j + 1, qi, hi); }
    if (!sB) finishSM(pB0, pB1, alB, l_reg, pa0, pa1, pa2, pa3); SBAR();
    if (SDEPTH == 1 || j + 3 < NT) SLOAD(SE, (j + 1 + SDEPTH) * KVBLK); SBAR();
    if (!sB) pv_d0(o, vb0 + SHM_V, pa0, pa1, pa2, pa3);
    if (!sA) partialSM(pA0, pA1, m_reg, mnA, alA); else alA = 1.f;
    __syncthreads(); SWAIT(); SWRITE(1, SO);
    RESC(alA); __syncthreads();
  }
  sB = SKIPT(kt_lo + NT - 1);
  SBAR(); if (!sB) { qkt(pB0, pB1, K_lds + SHM_K, qr, r32, hi); if (MASKT(kt_lo + NT - 1)) band_mask(pB0, pB1, kt_lo + NT - 1, qi, hi); }
  if (!sA) finishSM(pA0, pA1, alA, l_reg, pa0, pa1, pa2, pa3); SBAR();
  if (!sA) pv_d0(o, vb0, pa0, pa1, pa2, pa3);
  if (!sB) partialSM(pB0, pB1, m_reg, mnB, alB); else alB = 1.f;
  __syncthreads(); RESC(alB);
  if (!sB) { finishSM(pB0, pB1, alB, l_reg, pa0, pa1, pa2, pa3); SBAR();
    pv_d0(o, vb0 + SHM_V, pa0, pa1, pa2, pa3); }
  { constexpr float C = SCALE * 1.4426950408889634f; l_reg += __builtin_amdgcn_exp2f(sink16[hq] * 1.4426950408889634f - m_reg * C); }
  if (hi == 0) li_l[r32] = l_reg; asm volatile("s_waitcnt lgkmcnt(0)" ::: "memory");
  float rli[16];
#pragma unroll
  for (int r = 0; r < 16; ++r) rli[r] = __builtin_amdgcn_rcpf(li_l[crow(r, hi)]);
  gbf16* Ow = Oq + (size_t)(blk_row0 + qrel0) * D + hq * HD;
#pragma unroll
  for (int r = 0; r < 16; ++r) { const int orow = crow(r, hi);
#pragma unroll
    for (int d0 = 0; d0 < 4; ++d0) Ow[(size_t)orow * D + d0 * 32 + r32] = (bf16_t)(cvt_pk_bf16(o[d0][r] * rli[r], 0.f) & 0xffffu); }
#undef SLOAD
#undef SWRITE
#undef SWAIT
#undef RESC
#undef SKIPT
#undef MASKT
  __syncthreads();
}

__device__ __forceinline__ void sgu_stats_unit(const gbf16* SV, gf32* stats, int r0, int wave_s) {
  const int tid = make_tid(wave_s), wid = tid >> 6, lane = tid & 63;
#pragma unroll 1
  for (int rb = 0; rb < 16; rb += 4) {
    u32x4 w[4][4];
#pragma unroll
    for (int q = 0; q < 4; ++q)
#pragma unroll
      for (int j = 0; j < 4; ++j) w[q][j] = *(const GAS u32x4*)(SV + (size_t)(r0 + 16 * wid + rb + q) * D + lane * 8 + j * 512);
#pragma unroll
    for (int q = 0; q < 4; ++q) {
      float v[32];
#pragma unroll
      for (int j = 0; j < 4; ++j) { const u32x4 x = w[q][j];
        v[8 * j + 0] = bflo(x.x); v[8 * j + 1] = bfhi(x.x); v[8 * j + 2] = bflo(x.y); v[8 * j + 3] = bfhi(x.y); v[8 * j + 4] = bflo(x.z); v[8 * j + 5] = bfhi(x.z); v[8 * j + 6] = bflo(x.w); v[8 * j + 7] = bfhi(x.w); }
      float s = 0.f;
#pragma unroll
      for (int j = 0; j < 32; ++j) s += v[j];
      const float mean = wave_sum(s) * (1.0f / 2048.0f); float qq = 0.f;
#pragma unroll
      for (int j = 0; j < 32; ++j) { const float d = v[j] - mean; qq += d * d; }
      const float rstd = 1.0f / sqrtf(wave_sum(qq) * (1.0f / 2048.0f) + LN_EPS);
      if (lane == 0) *(GAS f32x2*)(stats + 2 * (size_t)(r0 + 16 * wid + rb + q)) = (f32x2){mean, rstd};
    }
  }
}

__device__ __forceinline__ void sgu_phase(const gbf16* SV, gbf16* U, gbf16* UO, const gf32* stats, const gbf16* swb  , const gf32* sb  ,
                                          const gf32* lng, const gf32* lnb, LAS char* lds, int wave_s, int G, int rev = 0) {
  const int tid = make_tid(wave_s), wid = tid >> 6, lane = tid & 63, r32 = lane & 31, hi = lane >> 5;
  const int sr = tid >> 4, sc = (tid & 15) * 8, k4 = (tid & 15) * 4;
  const int pb = wid & 3, dh = wid >> 2;
  constexpr int NU = 320 * 16, ZT_OFF = 65536, ZT_LD = 132;
  LAS float* Zt = (LAS float*)(lds + ZT_OFF);
  int idx = blockIdx.x;
  if (idx >= NU) return;
  u32x4 svr[4]; f32x2 str[4]; bf16x8 pan[8];
#define SGU_MAP(ix) (rev ? NU - 1 - (ix) : (ix))
#define SGU_ISSUE(ix) do { const int ch_ = SGU_MAP(ix) >> 4, g_ = SGU_MAP(ix) & 15, r0_ = ch_ * 128; \
    _Pragma("unroll") for (int i = 0; i < 4; ++i) { svr[i] = *(const GAS u32x4*)(SV + (size_t)(r0_ + sr + 32 * i) * D + g_ * 128 + sc); str[i] = *(const GAS f32x2*)(stats + 2 * (size_t)(r0_ + sr + 32 * i)); } \
    const gbf16* wp_ = swb + ((size_t)g_ * 128 + 32 * pb + r32) * 128 + 8 * hi; \
    _Pragma("unroll") for (int s = 0; s < 8; ++s) pan[s] = *(const GAS bf16x8*)(wp_ + 16 * s); } while (0)
  SGU_ISSUE(idx);
#pragma unroll 1
  for (int it = 0;; ++it) {
    const int g = SGU_MAP(idx) & 15, r0 = (SGU_MAP(idx) >> 4) * 128;
    LAS char* vbuf = lds + (it & 1) * 32768;
    { const f32x4 ga = *(const GAS f32x4*)(lng + g * 128 + sc), gb2 = *(const GAS f32x4*)(lng + g * 128 + sc + 4), ba = *(const GAS f32x4*)(lnb + g * 128 + sc), bb = *(const GAS f32x4*)(lnb + g * 128 + sc + 4);
#pragma unroll
      for (int i = 0; i < 4; ++i) { const int row = sr + 32 * i; const u32x4 w = svr[i]; const float mean = str[i].x, rstd = str[i].y;
        const float x[8] = { bflo(w.x), bfhi(w.x), bflo(w.y), bfhi(w.y), bflo(w.z), bfhi(w.z), bflo(w.w), bfhi(w.w) };
        float y[8];
#pragma unroll
        for (int e = 0; e < 4; ++e) { y[e] = (x[e] - mean) * rstd * ga[e] + ba[e]; y[4 + e] = (x[4 + e] - mean) * rstd * gb2[e] + bb[e]; }
        u32x4 ow; ow.x = cvt_pk_bf16(y[0], y[1]); ow.y = cvt_pk_bf16(y[2], y[3]); ow.z = cvt_pk_bf16(y[4], y[5]); ow.w = cvt_pk_bf16(y[6], y[7]);
        *(LAS u32x4*)(vbuf + (row >> 6) * SHM_V + v_st(row & 63, sc)) = ow; } }
    bf16x8 pa[8];
#pragma unroll
    for (int s = 0; s < 8; ++s) pa[s] = pan[s];
    u32x2 ur[4][2]; float bias[4];
#pragma unroll
    for (int j = 0; j < 4; ++j) { const gbf16* up = U + (size_t)(r0 + sr + 32 * j) * D + g * 128 + k4;
      ur[j][0] = *(const GAS u32x2*)up; ur[j][1] = *(const GAS u32x2*)(up + 64); bias[j] = sb[g * 128 + sr + 32 * j]; }
    const int nidx = idx + G; const bool has_next = nidx < NU;
    if (has_next) SGU_ISSUE(nidx);
    __syncthreads();
    const int vb0 = (int)(uintptr_t)vbuf + v_rd_base(lane) + dh * 1024;
    f32x16 o0 = {}, o1 = {};
    pv_one<0>(o0, vb0, pa[0], pa[1], pa[2], pa[3]); pv_one<1>(o1, vb0, pa[0], pa[1], pa[2], pa[3]);
    pv_one<0>(o0, vb0 + SHM_V, pa[4], pa[5], pa[6], pa[7]); pv_one<1>(o1, vb0 + SHM_V, pa[4], pa[5], pa[6], pa[7]);
#pragma unroll
    for (int r = 0; r < 16; ++r) { const int p = 32 * pb + crow(r, hi);
      Zt[p * ZT_LD + 64 * dh + r32] = o0[r]; Zt[p * ZT_LD + 64 * dh + 32 + r32] = o1[r]; }
    __syncthreads();
#pragma unroll
    for (int j = 0; j < 4; ++j) { const int row = sr + 32 * j; gbf16* up = UO + (size_t)(r0 + row) * D + g * 128 + k4;
#pragma unroll
      for (int h = 0; h < 2; ++h) { const f32x4 z = *(const LAS f32x4*)(Zt + row * ZT_LD + 64 * h + k4); const u32x2 uw = ur[j][h];
        u32x2 ow; ow.x = cvt_pk_bf16(bflo(uw.x) * (z[0] + bias[j]), bfhi(uw.x) * (z[1] + bias[j])); ow.y = cvt_pk_bf16(bflo(uw.y) * (z[2] + bias[j]), bfhi(uw.y) * (z[3] + bias[j]));
        *(GAS u32x2*)(up + 64 * h) = ow; } }
    if (!has_next) break;
    idx = nidx;
  }
#undef SGU_ISSUE
#undef SGU_MAP
  __syncthreads();
}
#undef KSWZ
#undef SBAR
}

#define XB_TMO      128
#define XB_XCNT(j)  (256  + 64 * (j))
#define XB_XSUB(j)  (1280 + 64 * (j))
#define XB_XGEN(j)  (2304 + 64 * (j))
#define XB_TOP      3328
#define XB_TOPGEN   3392
#define XCD_BAR_WORDS 3456
#define XB_SPIN_CAP (1u << 20)
__device__ __forceinline__ unsigned xb_ld(unsigned* p)              { return __hip_atomic_load(p, __ATOMIC_RELAXED, __HIP_MEMORY_SCOPE_AGENT); }
__device__ __forceinline__ unsigned xb_add(unsigned* p, unsigned v) { return __hip_atomic_fetch_add(p, v, __ATOMIC_RELAXED, __HIP_MEMORY_SCOPE_AGENT); }
__device__ __forceinline__ unsigned xb_xcc_id() { return (unsigned)__builtin_amdgcn_s_getreg((3 << 11) | 20) & 0xFu; }
#define XB_SPIN(cond, bar) do { unsigned _sp = 0; while (cond) { __builtin_amdgcn_s_sleep(1); \
    if ((++_sp & 255u) == 0u) { if (xb_ld(&(bar)[XB_TMO])) break; if (_sp > XB_SPIN_CAP) { atomicAdd(&(bar)[XB_TMO], 1u); break; } } } } while (0)
struct XcdBarrier { unsigned* bar; unsigned x; volatile LAS unsigned* st; };
__device__ __forceinline__ XcdBarrier xcd_barrier_post(unsigned* bar, volatile LAS unsigned* st) {
    XcdBarrier b; b.bar = bar; b.x = xb_xcc_id(); b.st = st;
    if (make_tid(wg_wave_index()) == 0) (void)xb_add(&bar[XB_XCNT(b.x)], 1u);
    return b;
}
__device__ __forceinline__ void xcd_barrier_complete(unsigned* bar, unsigned x, unsigned& nloc, unsigned& nx) {
    const unsigned G = gridDim.x * gridDim.y * gridDim.z;
    unsigned sum, cnt, mine, sp = 0u;
    for (;;) {
        sum = 0u; cnt = 0u; mine = 0u;
#pragma unroll 1
        for (unsigned j = 0; j < 16; ++j) { const unsigned c = xb_ld(&bar[XB_XCNT(j)]); sum += c; cnt += (c > 0u) ? 1u : 0u; mine = (j == x) ? c : mine; }
        if (sum == G) break;
        __builtin_amdgcn_s_sleep(1);
        if ((++sp & 255u) == 0u) { if (xb_ld(&bar[XB_TMO])) break; if (sp > XB_SPIN_CAP) { atomicAdd(&bar[XB_TMO], 1u); break; } }
    }
    nloc = mine > 0u ? mine : 1u; nx = cnt > 0u ? cnt : 1u;
}
__device__ __forceinline__ void xcd_barrier(const XcdBarrier& b, int wave_s) {
    asm volatile("s_waitcnt vmcnt(0)" ::: "memory");
    __syncthreads();
    if (make_tid(wave_s) == 0) {
        unsigned* bar = b.bar; asm volatile("" : "+s"(bar));
        __builtin_amdgcn_s_waitcnt(0);
        unsigned nloc = b.st[0], nx = b.st[1];
        if (nloc == 0u) { xcd_barrier_complete(bar, b.x, nloc, nx); b.st[0] = nloc; b.st[1] = nx; }
        const unsigned old = xb_add(&bar[XB_XSUB(b.x)], 1u);
        const unsigned gen = old / nloc;
        if (old + 1u == (gen + 1u) * nloc) {
            __builtin_amdgcn_fence(__ATOMIC_RELEASE, "agent");
            asm volatile("s_waitcnt vmcnt(0)" ::: "memory");
            const unsigned og = xb_add(&bar[XB_TOP], 1u);
            const unsigned tg = og / nx;
            if (og + 1u == (tg + 1u) * nx) xb_add(&bar[XB_TOPGEN], 1u);
            else XB_SPIN(xb_ld(&bar[XB_TOPGEN]) == tg, bar);
            __builtin_amdgcn_fence(__ATOMIC_ACQUIRE, "agent");
            xb_add(&bar[XB_XGEN(b.x)], 1u);
            asm volatile("s_waitcnt vmcnt(0)" ::: "memory");
        } else {
            XB_SPIN(xb_ld(&bar[XB_XGEN(b.x)]) == gen, bar);
            __builtin_amdgcn_fence(__ATOMIC_ACQUIRE, "agent");
            asm volatile("s_waitcnt vmcnt(0)" ::: "memory");
        }
    }
    __syncthreads();
}

struct Params {
    const float* x_prompt; const float* x_sample; const float* c_prompt; const float* c_sample;
    const float* w_ada; const float* b_ada; const float* ln_g; const float* ln_b;
    const float* ffn1_w_in; const float* ffn1_w_out; const float* w_mix_in; const float* attn_sink;
    const float* sgu_ln_g; const float* sgu_ln_b; const float* sgu_w; const float* sgu_b;
    const float* w_br_attn; const float* w_br_sgu; const float* w_mix_out; const float* ffn2_w_in; const float* ffn2_w_out;
    float* out; unsigned char* ws;
    float inv_freq[64];
    int ph_lo, ph_hi;
};

__device__ __forceinline__ int srcmap(int kind, int n) {
    if (kind == 0) return n;
    if (kind == 1) { const int t = n >> 8, j = n & 255; return j < 128 ? 128 * t + j : DFF + 128 * t + (j - 128); }
    if (n < ZU) return OFF_Q + (n & ~127) + dperm(n & 127);
    if (n < ZSV) return OFF_U + (n - ZU);
    if (n < ZGA) return OFF_SV + (n - ZSV);
    if (n < ZGB) return OFF_GA + (n - ZGA);
    if (n < ZK) return OFF_GB + (n - ZGB);
    if (n < ZV) { const int m = n - ZK; return OFF_K + (m & ~127) + dperm(m & 127); }
    return OFF_V + (n - ZV);
}
struct CvItem { const gf32* W; gbf16* WT; int K, N, kind, item, ldk; };
__device__ __forceinline__ void cv_load(const CvItem& c, int lane, float (&wv)[32]) {
    const int nblk = c.N / 32, kb = c.item / nblk, nb = c.item % nblk, k0 = 64 * kb, n0 = 32 * nb;
    const int scol = srcmap(c.kind, n0 + (lane & 31));
#pragma unroll
    for (int i = 0; i < 32; ++i) wv[i] = c.W[(size_t)(k0 + 2 * i + (lane >> 5)) * c.N + scol];
}
__device__ __forceinline__ void cv_store(const CvItem& c, int lane, LAS float* scr, const float (&wv)[32]) {
    const int nblk = c.N / 32, kb = c.item / nblk, nb = c.item % nblk, k0 = 64 * kb, n0 = 32 * nb;
#pragma unroll
    for (int i = 0; i < 32; ++i) scr[(2 * i + (lane >> 5)) * 33 + (lane & 31)] = wv[i];
    asm volatile("s_waitcnt lgkmcnt(0)" ::: "memory");
    const int cc = lane & 7;
#pragma unroll
    for (int j = 0; j < 4; ++j) { const int n = (lane >> 3) + 8 * j; const LAS float* s = scr + (8 * cc) * 33 + n;
        u32x4 o; o.x = cvt_pk_bf16(s[0 * 33], s[1 * 33]); o.y = cvt_pk_bf16(s[2 * 33], s[3 * 33]); o.z = cvt_pk_bf16(s[4 * 33], s[5 * 33]); o.w = cvt_pk_bf16(s[6 * 33], s[7 * 33]);
        *(GAS u32x4*)(c.WT + (size_t)(n0 + n) * c.ldk + k0 + 8 * cc) = o; }
    asm volatile("s_waitcnt lgkmcnt(0)" ::: "memory");
}
__device__ __forceinline__ void cv_decode(const Params& P, int l, gbf16* wt, int it, CvItem& c) {
    constexpr int I_FIN = (D / 64) * (NIN / 32), I_FOUT = (DFF / 64) * (D / 32), I_SQ = (D / 64) * (D / 32);
    int r = it;
    if (r < I_FIN) { c = CvItem{(const gf32*)P.ffn1_w_in + (size_t)l * D * NIN, wt + WT_FFN1_IN / 2, D, NIN, 1, r, D}; return; } r -= I_FIN;
    if (r < I_FOUT) { c = CvItem{(const gf32*)P.ffn1_w_out + (size_t)l * DFF * D, wt + WT_FFN1_OUT / 2, DFF, D, 0, r, DFF}; return; } r -= I_FOUT;
    if (r < I_FIN) { c = CvItem{(const gf32*)P.w_mix_in + (size_t)l * D * NIN, wt + WT_MIX_IN / 2, D, NIN, 2, r, D}; return; } r -= I_FIN;
    if (r < I_SQ) { c = CvItem{(const gf32*)P.w_br_attn + (size_t)l * D * D, wt + WT_BRA / 2, D, D, 0, r, 2 * D}; return; } r -= I_SQ;
    if (r < I_SQ) { c = CvItem{(const gf32*)P.w_br_sgu + (size_t)l * D * D, wt + WT_BRA / 2 + D, D, D, 0, r, 2 * D}; return; } r -= I_SQ;
    if (r < I_SQ) { c = CvItem{(const gf32*)P.w_mix_out + (size_t)l * D * D, wt + WT_MO / 2, D, D, 0, r, D}; return; } r -= I_SQ;
    if (r < I_FIN) { c = CvItem{(const gf32*)P.ffn2_w_in + (size_t)l * D * NIN, wt + WT_FFN2_IN / 2, D, NIN, 1, r, D}; return; } r -= I_FIN;
    c = CvItem{(const gf32*)P.ffn2_w_out + (size_t)l * DFF * D, wt + WT_FFN2_OUT / 2, DFF, D, 0, r, DFF};
}
#ifndef CV_TAIL_PCT
#define CV_TAIL_PCT 60
#endif
__device__ __forceinline__ void convert_group(const Params& P, int l, int grp, int part, LAS unsigned char* lds, int wave_s, int worker, int nworkers) {
    const int tid_ = make_tid(wave_s);
    const int lane = tid_ & 63, wave = __builtin_amdgcn_readfirstlane(tid_ >> 6), gw = worker * 8 + wave, NGW = nworkers * 8;
    LAS float* scr = (LAS float*)(lds + wave * 8704);
    gu8* wsb = (gu8*)P.ws; asm volatile("" : "+s"(wsb));
    gbf16* wt = (gbf16*)(wsb + WS_WT);
    constexpr int I_FIN = (D / 64) * (NIN / 32), I_FOUT = (DFF / 64) * (D / 32), I_SQ = (D / 64) * (D / 32);
    constexpr int E1 = I_FIN + I_FOUT, E2 = E1 + I_FIN + 3 * I_SQ, E3 = E2 + I_FIN + I_FOUT;
    const int g_lo = grp == 1 ? 0 : grp == 2 ? E1 : E2, g_hi = grp == 1 ? E1 : grp == 2 ? E2 : E3;
    const int cut = g_lo + (int)((long)(g_hi - g_lo) * CV_TAIL_PCT / 100);
    const int it_lo = part < 0 ? g_lo : part == 0 ? g_lo : cut, it_hi = part < 0 ? g_hi : part == 0 ? cut : g_hi;
    int it = it_lo + gw; if (it >= it_hi) return;
    CvItem cur, nxt; float wvn[32];
    cv_decode(P, l, wt, it, cur); cv_load(cur, lane, wvn);
#pragma unroll 1
    for (;;) {
        float wv[32];
#pragma unroll
        for (int i = 0; i < 32; ++i) wv[i] = wvn[i];
        const int itn = it + NGW; const bool has_next = itn < it_hi;
        if (has_next) { cv_decode(P, l, wt, itn, nxt); cv_load(nxt, lane, wvn); }
        cv_store(cur, lane, scr, wv);
        if (!has_next) break;
        cur = nxt; it = itn;
    }
}
__device__ __forceinline__ void convert_in_tail(const Params& P, int l, int grp, LAS unsigned char* lds, int wave_s, int G, int c) {
    constexpr int nwg = (M / 256) * (NIN / 256);
    const int rem = nwg % G;
    if (rem == 0) convert_group(P, l, grp, 0, lds, wave_s, c, G);
    else if (c >= rem) convert_group(P, l, grp, 0, lds, wave_s, c - rem, G - rem);
}
__device__ __forceinline__ void sincos_d(double x, double& s, double& c) {
    const double q = rint(x * 0.63661977236758134308);
    double r = fma(-q, 1.57079632673412561417e+00, x); r = fma(-q, 6.07710050650619224932e-11, r);
    const double r2 = r * r;
    const double sp = r + r * r2 * (-1.66666666666666324348e-01 + r2 * (8.33333333332248946124e-03 + r2 * (-1.98412698298579493134e-04 + r2 * (2.75573137070700676789e-06 + r2 * (-2.50507602534068634195e-08 + r2 * 1.58969099521155010221e-10)))));
    const double cp = 1.0 - 0.5 * r2 + r2 * r2 * (4.16666666666666019037e-02 + r2 * (-1.38888888888741095749e-03 + r2 * (2.48015872894767294178e-05 + r2 * (-2.75573143513906633035e-07 + r2 * (2.08757232129817482790e-09 + r2 * -1.13596475577881948265e-11)))));
    const int n = ((int)q) & 3;
    s = (n == 0) ? sp : (n == 1) ? cp : (n == 2) ? -sp : -cp;
    c = (n == 0) ? cp : (n == 1) ? -sp : (n == 2) ? -cp : sp;
}

template <int MODE>
__device__ __forceinline__ void row_phase(const Params& P, LAS unsigned char* lds, const gf32* lng, const gf32* lnb, const gf32* modl_  , int jshift, int wave_s, int rev = 0) {
    const int tid = make_tid(wave_s), lane = tid & 63, wave = __builtin_amdgcn_readfirstlane(tid >> 6);
    LAS float* G = (LAS float*)lds; LAS float* Bv = G + 2048; LAS float* SC = Bv + 2048; LAS float* SH = SC + 2048;
    gu8* wsb = (gu8*)P.ws; gf32* xout = (gf32*)P.out; asm volatile("" : "+s"(wsb), "+s"(xout));
    gbf16* hbuf = (gbf16*)(wsb + WS_H); gf32* rsb = (gf32*)(wsb + WS_RS); const GAS unsigned short* ybuf = (const GAS unsigned short*)(wsb + WS_Y);
    __syncthreads();
    if (MODE != 0) { for (int i = tid; i < 2048; i += 512) { G[i] = lng[i]; Bv[i] = lnb[i]; } }
    int curb = -1;
    constexpr int NL = (MODE == 0) ? 8 : 4;
    u32x4 nv[NL], nv2[NL];
#define ROW_TT(q_) ((int)blockIdx.x + ((q_) >> 2) * (int)gridDim.x)
#define ROW_AT(q_) (ROW_TT(q_) < M / 32 ? ((rev ? (M / 32 - 1 - ROW_TT(q_)) : ROW_TT(q_)) * 32 + wave * 4 + ((q_) & 3)) : M)
#define ROW_LOAD(dst, row_) do { if (MODE == 0) { const gf32* src_ = ((row_) < MP) ? (const gf32*)P.x_prompt + (size_t)(row_) * D : (const gf32*)P.x_sample + (size_t)((row_) - MP) * D; \
        _Pragma("unroll") for (int j = 0; j < NL; ++j) dst[j] = *(const GAS u32x4*)(src_ + 4 * (lane + 64 * j)); } \
      else { const GAS unsigned short* src_ = ybuf + (size_t)(row_) * D; _Pragma("unroll") for (int j = 0; j < NL; ++j) dst[j] = *(const GAS u32x4*)(src_ + 8 * (lane + 64 * j)); } } while (0)
    { const int r0_ = ROW_AT(0), r1_ = ROW_AT(1); if (r0_ < M) ROW_LOAD(nv, r0_); if (r1_ < M) ROW_LOAD(nv2, r1_); }
    int qidx = 0;
    for (int t = blockIdx.x; t < M / 32; t += gridDim.x) {
        const int row0 = (rev ? (M / 32 - 1 - t) : t) * 32, b = batch_of(row0);
        if (b != curb) {
            __syncthreads();
            if (MODE != 2) { const gf32* sh = modl_ + ((size_t)b * NMOD + jshift) * D; const gf32* sc = sh + D;
                for (int i = tid; i < 2048; i += 512) { SH[i] = sh[i]; SC[i] = 1.0f + sc[i]; } }
            __syncthreads(); curb = b;
        }
#pragma unroll 1
        for (int rr = 0; rr < 4; ++rr, ++qidx) {
            const int row = row0 + wave * 4 + rr;
            u32x4 cw[NL];
#pragma unroll
            for (int j = 0; j < NL; ++j) { cw[j] = nv[j]; nv[j] = nv2[j]; }
            { const int nrow = ROW_AT(qidx + 2); if (nrow < M) ROW_LOAD(nv2, nrow); }
            f32x4 v[8];
            if (MODE == 0) {
#pragma unroll
                for (int j = 0; j < 8; ++j) v[j] = __builtin_bit_cast(f32x4, cw[j]);
            } else {
#pragma unroll
                for (int j = 0; j < 4; ++j) { v[2 * j] = (f32x4){f16lo(cw[j].x), f16hi(cw[j].x), f16lo(cw[j].y), f16hi(cw[j].y)}; v[2 * j + 1] = (f32x4){f16lo(cw[j].z), f16hi(cw[j].z), f16lo(cw[j].w), f16hi(cw[j].w)}; }
            }
#define CBASE(jj) ((MODE == 0) ? 4 * (lane + 64 * (jj)) : 8 * (lane + 64 * ((jj) >> 1)) + 4 * ((jj) & 1))
            if (MODE != 0) {
                float s = 0.f;
#pragma unroll
                for (int j = 0; j < 8; ++j) s += (v[j][0] + v[j][1]) + (v[j][2] + v[j][3]);
                const float mean = wave_sum(s) * (1.0f / D); float q = 0.f;
#pragma unroll
                for (int j = 0; j < 8; ++j) { v[j] = v[j] - mean; q += (v[j][0] * v[j][0] + v[j][1] * v[j][1]) + (v[j][2] * v[j][2] + v[j][3] * v[j][3]); }
                const float rstd = 1.0f / sqrtf(wave_sum(q) * (1.0f / D) + LN_EPS);
                if (MODE == 1 && lane == 0) *(GAS f32x2*)(rsb + 2 * (size_t)row) = (f32x2){mean, rstd};
#pragma unroll
                for (int j = 0; j < 8; ++j) { const int c = CBASE(j);
                    const f32x4 gg = *(const LAS f32x4*)(G + c), bb = *(const LAS f32x4*)(Bv + c);
                    v[j] = v[j] * rstd * gg + bb;
                    if (MODE == 2) *(GAS f32x4*)(xout + (size_t)row * D + c) = v[j]; }
            }
            if (MODE != 2) {
                if (MODE == 0) {
#pragma unroll
                    for (int j = 0; j < 8; ++j) { const int c = CBASE(j);
                        const f32x4 sc = *(const LAS f32x4*)(SC + c), sh = *(const LAS f32x4*)(SH + c);
                        const f32x4 h = v[j] * sc + sh;
                        u32x2 w; w.x = cvt_pk_bf16(h[0], h[1]); w.y = cvt_pk_bf16(h[2], h[3]);
                        *(GAS u32x2*)(hbuf + (size_t)row * D + c) = w; }
                } else {
#pragma unroll
                    for (int j = 0; j < 4; ++j) { const int c = CBASE(2 * j);
                        const f32x4 sc0 = *(const LAS f32x4*)(SC + c), sh0 = *(const LAS f32x4*)(SH + c), sc1 = *(const LAS f32x4*)(SC + c + 4), sh1 = *(const LAS f32x4*)(SH + c + 4);
                        const f32x4 h0 = v[2 * j] * sc0 + sh0, h1 = v[2 * j + 1] * sc1 + sh1;
                        u32x4 w; w.x = cvt_pk_bf16(h0[0], h0[1]); w.y = cvt_pk_bf16(h0[2], h0[3]); w.z = cvt_pk_bf16(h1[0], h1[1]); w.w = cvt_pk_bf16(h1[2], h1[3]);
                        *(GAS u32x4*)(hbuf + (size_t)row * D + c) = w; }
                }
            }
#undef CBASE
        }
    }
#undef ROW_AT
#undef ROW_TT
#undef ROW_LOAD
    __syncthreads();
}

__global__ void __launch_bounds__(512, 2) hybrid_fwd(Params P) {
    extern __shared__ __attribute__((aligned(16))) unsigned char lds_raw[];
    LAS unsigned char* lds = (LAS unsigned char*)lds_raw;
    const int G = gridDim.x;
    const int wave_s_ = wg_wave_index();
    volatile LAS unsigned* MISC = (volatile LAS unsigned*)(lds + MISC_OFF);
    { const int t0 = make_tid(wave_s_); if (t0 < 8) MISC[t0] = 0u; }
    __syncthreads();
    unsigned* ctl = (unsigned*)(P.ws + WS_CTL);
    XcdBarrier bar; bar.bar = ctl + CW_BAR; bar.x = 0; bar.st = MISC;
    if (!MK_PER_PHASE) bar = xcd_barrier_post(ctl + CW_BAR, MISC);
    const int lo = P.ph_lo, hi = P.ph_hi;
    int ph = 0, dirx = 1;
#ifndef PHMASK
#define PHMASK 0xFFFFF
#endif
#define SITE(id) (((PHMASK) >> (id)) & 1)
#define PH_ON (ph >= lo && ph < hi)
#define PH_REV (dirx)
#define PH_END do { if (!MK_PER_PHASE && ph + 1 < hi) xcd_barrier(bar, wave_s_); } while (0)
#define PH_LOCALS gu8* wsb = (gu8*)P.ws; int wv = wave_s_; asm volatile("" : "+s"(wsb), "+s"(wv)); const int wave_s = wv; \
    gf32* mod = (gf32*)(wsb + WS_MOD); gf32* cosT = (gf32*)(wsb + WS_COS); gf32* sinT = (gf32*)(wsb + WS_SIN); gbf16* swb = (gbf16*)(wsb + WS_SW); gf32* stats = (gf32*)(wsb + WS_ST); \
    gbf16* wt = (gbf16*)(wsb + WS_WT); gbf16* hbuf = (gbf16*)(wsb + WS_H); gbf16* zbuf = (gbf16*)(wsb + WS_Z); \
    (void)mod; (void)cosT; (void)sinT; (void)swb; (void)wt; (void)hbuf; (void)zbuf; (void)wave_s; (void)stats;
#define modl (mod + (size_t)l * NB * NMOD * D)

    if (SITE(0) && PH_ON) { PH_LOCALS
        convert_group(P, 0, 1, -1, lds, wave_s, (int)blockIdx.x, G);
        const int tid = make_tid(wave_s), lane = tid & 63, wave = __builtin_amdgcn_readfirstlane(tid >> 6);
        const int gt = blockIdx.x * 512 + tid, NGT = G * 512;
#pragma unroll 1
        for (int rep = DUP(9) ? 0 : 1; rep < 2; ++rep) {
        for (int i = gt; i < DEPTH * 16 * 128 * 128 / 2; i += NGT) { const f32x2 v = *(const GAS f32x2*)((const gf32*)P.sgu_w + 2 * (size_t)i); ((GAS unsigned*)swb)[i] = cvt_pk_bf16(v.x, v.y); }
        for (int i = gt; i < 8192 * 64; i += NGT) { const int pos = i >> 6, j = i & 63; const float ang = (float)pos * P.inv_freq[j]; double s, c; sincos_d((double)ang, s, c); cosT[i] = (float)c; sinT[i] = (float)s; }
        __syncthreads();
        LAS float* scv = (LAS float*)lds;
        LAS float* red = (LAS float*)(lds + 49152);
        for (int i = tid; i < NB * D; i += 512) { const int b = i >> 11, k = i & 2047; const float cv = (b < 2) ? ((const gf32*)P.c_prompt)[b * D + k] : ((const gf32*)P.c_sample)[(b - 2) * D + k]; scv[i] = silu_f(cv); }
        __syncthreads();
        constexpr int NCH = NMOD * D / 64;
        for (int it = blockIdx.x; it < DEPTH * NCH; it += G) {
            const int l = it / NCH, ch = it % NCH; const gf32* wp = (const gf32*)P.w_ada + (size_t)l * D * (NMOD * D) + (size_t)(256 * wave) * (NMOD * D) + ch * 64 + lane;
            float a[NB] = {0.f, 0.f, 0.f, 0.f, 0.f, 0.f};
#pragma unroll 1
            for (int k0 = 0; k0 < 256; k0 += 32) { float wv[32];
#pragma unroll
                for (int k = 0; k < 32; ++k) wv[k] = wp[(size_t)(k0 + k) * (NMOD * D)];
#pragma unroll
                for (int k = 0; k < 32; ++k)
#pragma unroll
                    for (int b = 0; b < NB; ++b) a[b] += scv[b * D + 256 * wave + k0 + k] * wv[k]; }
#pragma unroll
            for (int b = 0; b < NB; ++b) red[(wave * NB + b) * 64 + lane] = a[b];
            __syncthreads();
            if (tid < NB * 64) { const int b = tid >> 6, c = tid & 63; float s = 0.f;
#pragma unroll
                for (int w = 0; w < 8; ++w) s += red[(w * NB + b) * 64 + c];
                const int n = ch * 64 + c; mod[((size_t)l * NB + b) * (NMOD * D) + n] = s + ((const gf32*)P.b_ada)[(size_t)l * NMOD * D + n]; }
            __syncthreads();
        }
        if (rep == 0) xcd_barrier(bar, wave_s_); }
        PH_END;
    }
    ++ph; dirx ^= 1;
    if (SITE(1) && PH_ON) { PH_LOCALS row_phase<0>(P, lds, nullptr, nullptr, mod, 0, wave_s); if (DUP(1)) { xcd_barrier(bar, wave_s_); row_phase<0>(P, lds, nullptr, nullptr, mod, 0, wave_s); } PH_END; }
    ++ph; dirx ^= 1;

    for (int l = 0; l < DEPTH; ++l) {
        for (int half = 0; half < 2; ++half) {
            const int sub = 2 * half;
            if (SITE(2) && PH_ON) { PH_LOCALS
                pg8::Gemm g{hbuf, wt + (half ? WT_FFN2_IN : WT_FFN1_IN) / 2}; pg8::StaticOrder<NIN> S; S.init(G, (int)blockIdx.x, PH_REV);
                pg8::EpiSwiglu E{zbuf};
                pg8::gemm_phase<pg8::EpiSwiglu, NIN, D, D, true, true>(lds, g, S, E, wave_s);
                if (half == 0) convert_in_tail(P, l, 2, lds, wave_s, G, (int)blockIdx.x);
                else if (l + 1 < DEPTH) convert_in_tail(P, l + 1, 1, lds, wave_s, G, (int)blockIdx.x);
                if (DUP(2)) { xcd_barrier(bar, wave_s_); pg8::gemm_phase<pg8::EpiSwiglu, NIN, D, D, true, true>(lds, g, S, E, wave_s); }
#ifdef PROBE_TILED
                { xcd_barrier(bar, wave_s_); pg8::EpiNone E0; pg8::gemm_phase<pg8::EpiNone, NIN, D, 64, true, true, 64, 32768, 32768>(lds, g, S, E0, wave_s); }
#endif
#ifdef PROBE_ROWMAJ
                { xcd_barrier(bar, wave_s_); pg8::EpiNone E0; pg8::gemm_phase<pg8::EpiNone, NIN, D, D, true, true>(lds, g, S, E0, wave_s); }
#endif
                PH_END;
            }
            ++ph; dirx ^= 1;
            if (SITE(3) && PH_ON) { PH_LOCALS
                pg8::Gemm g{zbuf, wt + (half ? WT_FFN2_OUT : WT_FFN1_OUT) / 2}; pg8::StaticOrder<D> S; S.init(G, (int)blockIdx.x, PH_REV);
                const bool first = (l == 0 && half == 0);
                GAS unsigned short* yb = (GAS unsigned short*)(wsb + WS_Y);
                if (DUP(3)) { pg8::EpiNone E0; pg8::gemm_phase<pg8::EpiNone, D, DFF, DFF, true, true>(lds, g, S, E0, wave_s); xcd_barrier(bar, wave_s_); }
                const int pl = half ? l : l - 1, psub = half ? 1 : 2;
                const gf32* plg = (const gf32*)P.ln_g + ((size_t)(first ? 0 : pl) * 3 + psub) * D; const gf32* plb = (const gf32*)P.ln_b + ((size_t)(first ? 0 : pl) * 3 + psub) * D;
                if (first) { pg8::EpiResid<0> E{(const gf32*)P.x_prompt, (const gf32*)P.x_sample, yb, modl + (size_t)(3 * sub + 2) * D, (const gf32*)(wsb + WS_RS), plg, plb, 0.5f};
                    pg8::gemm_phase<pg8::EpiResid<0>, D, DFF, DFF, true, true>(lds, g, S, E, wave_s); }
                else { pg8::EpiResid<1> E{(const gf32*)P.x_prompt, (const gf32*)P.x_sample, yb, modl + (size_t)(3 * sub + 2) * D, (const gf32*)(wsb + WS_RS), plg, plb, 0.5f};
                    pg8::gemm_phase<pg8::EpiResid<1>, D, DFF, DFF, true, true>(lds, g, S, E, wave_s); }
                PH_END;
            }
            ++ph; dirx ^= 1;
            if (SITE(4) && PH_ON) { PH_LOCALS
                const gf32* lg = (const gf32*)P.ln_g + ((size_t)l * 3 + sub) * D; const gf32* lb = (const gf32*)P.ln_b + ((size_t)l * 3 + sub) * D;
                if (DUP(4) && !(half == 1 && l + 1 >= DEPTH)) { if (half == 0) row_phase<1>(P, lds, lg, lb, modl, 3, wave_s); else row_phase<1>(P, lds, lg, lb, modl + (size_t)NB * NMOD * D, 0, wave_s); xcd_barrier(bar, wave_s_); }
                if (half == 0) { convert_group(P, l, 2, 1, lds, wave_s, (int)blockIdx.x, G); row_phase<1>(P, lds, lg, lb, modl, 3, wave_s, PH_REV); }
                else if (l + 1 < DEPTH) { convert_group(P, l + 1, 1, 1, lds, wave_s, (int)blockIdx.x, G); row_phase<1>(P, lds, lg, lb, modl + (size_t)NB * NMOD * D, 0, wave_s, PH_REV); }
                else row_phase<2>(P, lds, lg, lb, modl, 0, wave_s, PH_REV);
                PH_END;
            }
            ++ph; dirx ^= 1;
            if (half == 1) break;
            if (SITE(5) && PH_ON) { PH_LOCALS
                pg8::Gemm g{hbuf, wt + WT_MIX_IN / 2}; pg8::StaticOrder<NIN> S; S.init(G, (int)blockIdx.x, PH_REV);
                pg8::EpiMix E{zbuf, cosT, sinT, (gf32*)P.out};
                pg8::gemm_phase<pg8::EpiMix, NIN, D, D, true, true>(lds, g, S, E, wave_s);
                convert_in_tail(P, l, 3, lds, wave_s, G, (int)blockIdx.x);
                PH_END;
            }
            ++ph; dirx ^= 1;
            if (SITE(6) && PH_ON) { PH_LOCALS
                { const int tid = make_tid(wave_s); const gf32* sp = (const gf32*)P.out;
#pragma unroll 1
                  for (int r = blockIdx.x * 512 + tid; r < M; r += G * 512) { float s1 = 0.f, s2 = 0.f;
#pragma unroll
                      for (int j = 0; j < 16; ++j) { const f32x4 p = *(const GAS f32x4*)(sp + (size_t)r * 64 + 4 * j); s1 += p[0] + p[2]; s2 += p[1] + p[3]; }
                      const float mean = s1 * (1.0f / 2048.0f), var = fmaxf(s2 * (1.0f / 2048.0f) - mean * mean, 0.f);
                      *(GAS f32x2*)(stats + 2 * (size_t)r) = (f32x2){mean, 1.0f / sqrtf(var + LN_EPS)}; } }
#pragma unroll 1
                for (int rep = DUP(6) ? 0 : 1; rep < 2; ++rep) {
#pragma unroll 1
                for (int idx_ = blockIdx.x; idx_ < 2560; idx_ += G) {
                    const int idx = PH_REV ? 2559 - idx_ : idx_;
                    const int blk = idx >> 3, gk = (idx >> 1) & 3, hp = idx & 1; int seq_row0, nb, nblk;
                    if (blk < 64) { seq_row0 = (blk >> 5) * 4096; nb = blk & 31; nblk = 32; }
                    else { const int b2 = blk - 64; seq_row0 = MP + (b2 >> 6) * 8192; nb = b2 & 63; nblk = 64; }
                    att::attn_unit(zbuf + ZB_Q, (DUP(6) && rep == 0) ? hbuf : zbuf + ZB_Q, zbuf + ZB_K, zbuf + ZB_V, seq_row0, nb, nblk, gk, hp, (const gf32*)P.attn_sink + l * NHQ, (LAS char*)lds, wave_s);
                }
                if (rep == 0) xcd_barrier(bar, wave_s_); }
                PH_END;
            }
            ++ph;
            if (SITE(7) && PH_ON) { PH_LOCALS
                if (DUP(7)) { att::sgu_phase(zbuf + ZB_SV, zbuf + ZB_U, hbuf, stats, swb + (size_t)l * 16 * 128 * 128, (const gf32*)P.sgu_b + (size_t)l * 16 * 128, (const gf32*)P.sgu_ln_g + (size_t)l * D, (const gf32*)P.sgu_ln_b + (size_t)l * D, (LAS char*)lds, wave_s, G); xcd_barrier(bar, wave_s_); }
                att::sgu_phase(zbuf + ZB_SV, zbuf + ZB_U, zbuf + ZB_U, stats, swb + (size_t)l * 16 * 128 * 128, (const gf32*)P.sgu_b + (size_t)l * 16 * 128, (const gf32*)P.sgu_ln_g + (size_t)l * D, (const gf32*)P.sgu_ln_b + (size_t)l * D, (LAS char*)lds, wave_s, G, PH_REV);
                PH_END;
            }
            ++ph; dirx ^= 1;
            if (SITE(8) && PH_ON) { PH_LOCALS
                pg8::Gemm g{zbuf + ZB_Q, wt + WT_BRA / 2}; pg8::StaticOrder<D> S; S.init(G, (int)blockIdx.x, PH_REV);
                pg8::EpiBranchF E{hbuf, zbuf + ZB_GA, zbuf + ZB_GB};
                pg8::gemm_phase<pg8::EpiBranchF, D, 2 * D, D, true, true, 2 * D, 128, 128, 32, (size_t)M * D * 2 - 32 * 128>(lds, g, S, E, wave_s);
                PH_END;
            }
            ++ph; dirx ^= 1;
            if (SITE(10) && PH_ON) { PH_LOCALS
                pg8::Gemm g{hbuf, wt + WT_MO / 2}; pg8::StaticOrder<D> S; S.init(G, (int)blockIdx.x, PH_REV);
                GAS unsigned short* yb = (GAS unsigned short*)(wsb + WS_Y);
                pg8::EpiResid<1> E{(const gf32*)P.x_prompt, (const gf32*)P.x_sample, yb, modl + (size_t)(3 * 1 + 2) * D, (const gf32*)(wsb + WS_RS), (const gf32*)P.ln_g + ((size_t)l * 3 + 0) * D, (const gf32*)P.ln_b + ((size_t)l * 3 + 0) * D, 1.0f};
                pg8::gemm_phase<pg8::EpiResid<1>, D, D, D, true, true>(lds, g, S, E, wave_s);
                PH_END;
            }
            ++ph; dirx ^= 1;
            if (SITE(11) && PH_ON) { PH_LOCALS
                convert_group(P, l, 3, 1, lds, wave_s, (int)blockIdx.x, G);
                row_phase<1>(P, lds, (const gf32*)P.ln_g + ((size_t)l * 3 + 1) * D, (const gf32*)P.ln_b + ((size_t)l * 3 + 1) * D, modl, 6, wave_s, PH_REV);
                if (DUP(4)) { xcd_barrier(bar, wave_s_); row_phase<1>(P, lds, (const gf32*)P.ln_g + ((size_t)l * 3 + 1) * D, (const gf32*)P.ln_b + ((size_t)l * 3 + 1) * D, modl, 6, wave_s); }
                PH_END;
            }
            ++ph; dirx ^= 1;
        }
    }
#undef PH_ON
#undef PH_END
}

constexpr int N_PHASES = 2 + DEPTH * 12;

extern "C" void kernel_launch(void* const* d_in, const int* in_sizes, int n_in, void* d_out, int out_size, void* d_ws, size_t ws_size, hipStream_t stream) {
    static int grid = 0;
    if (grid == 0) {
        if (n_in != 21 || in_sizes[0] != MP * D || in_sizes[1] != MS * D || out_size != M * D || ws_size < WS_END) {
            fprintf(stderr, "kernel_launch: shape mismatch n_in %d in0 %d in1 %d out %d ws %zu (need %zu)\n", n_in, n_in > 0 ? in_sizes[0] : -1, n_in > 1 ? in_sizes[1] : -1, out_size, ws_size, (size_t)WS_END);
            grid = -1; return; }
        int dev = 0, cus = 0;
        if (hipGetDevice(&dev) != hipSuccess || hipDeviceGetAttribute(&cus, hipDeviceAttributeMultiprocessorCount, dev) != hipSuccess) { grid = -1; return; }
        if (hipFuncSetAttribute((const void*)hybrid_fwd, hipFuncAttributeMaxDynamicSharedMemorySize, LDS_BYTES) != hipSuccess) { fprintf(stderr, "kernel_launch: hipFuncSetAttribute failed\n"); grid = -1; return; }
        int per_cu = 0;
        if (hipOccupancyMaxActiveBlocksPerMultiprocessor(&per_cu, (const void*)hybrid_fwd, 512, LDS_BYTES) != hipSuccess || per_cu < 1) {
            fprintf(stderr, "kernel_launch: occupancy query reports %d blocks per CU\n", per_cu); }
        (void)hipGetLastError();
        grid = cus;
    }
    if (grid < 0) return;
    (void)hipMemsetAsync((char*)d_ws + WS_CTL, 0, CTL_ZERO_BYTES, stream);
    Params p{};
    p.x_prompt = (const float*)d_in[0]; p.x_sample = (const float*)d_in[1]; p.c_prompt = (const float*)d_in[2]; p.c_sample = (const float*)d_in[3];
    p.w_ada = (const float*)d_in[4]; p.b_ada = (const float*)d_in[5]; p.ln_g = (const float*)d_in[6]; p.ln_b = (const float*)d_in[7];
    p.ffn1_w_in = (const float*)d_in[8]; p.ffn1_w_out = (const float*)d_in[9]; p.w_mix_in = (const float*)d_in[10]; p.attn_sink = (const float*)d_in[11];
    p.sgu_ln_g = (const float*)d_in[12]; p.sgu_ln_b = (const float*)d_in[13]; p.sgu_w = (const float*)d_in[14]; p.sgu_b = (const float*)d_in[15];
    p.w_br_attn = (const float*)d_in[16]; p.w_br_sgu = (const float*)d_in[17]; p.w_mix_out = (const float*)d_in[18]; p.ffn2_w_in = (const float*)d_in[19]; p.ffn2_w_out = (const float*)d_in[20];
    p.out = (float*)d_out; p.ws = (unsigned char*)d_ws;
    for (int j = 0; j < 64; ++j) { const float t = powf(10000.0f, (float)j / 64.0f); p.inv_freq[j] = 1.0f / t; }
#if MK_PER_PHASE
    for (int k = 0; k < N_PHASES; ++k) { p.ph_lo = k; p.ph_hi = k + 1; hipLaunchKernelGGL(hybrid_fwd, dim3(grid), dim3(512), LDS_BYTES, stream, p); }
#else
#ifdef PROBE_FIRST
    p.ph_lo = 0; p.ph_hi = PROBE_K;
    hipLaunchKernelGGL(hybrid_fwd, dim3(grid), dim3(512), LDS_BYTES, stream, p);
    (void)hipMemsetAsync((char*)d_ws + WS_CTL, 0, CTL_ZERO_BYTES, stream);
#endif
    p.ph_lo = 0; p.ph_hi = N_PHASES;
    hipLaunchKernelGGL(hybrid_fwd, dim3(grid), dim3(512), LDS_BYTES, stream, p);
#ifdef PROBE_TWICE
    (void)hipMemsetAsync((char*)d_ws + WS_CTL, 0, CTL_ZERO_BYTES, stream);
    p.ph_lo = PROBE_LO; p.ph_hi = PROBE_HI;
    hipLaunchKernelGGL(hybrid_fwd, dim3(grid), dim3(512), LDS_BYTES, stream, p);
#endif
#endif
    const hipError_t le = hipPeekAtLastError();
    if (le != hipSuccess) fprintf(stderr, "kernel_launch: launch failed: %s\n", hipGetErrorName(le));
}
```

```cpp
#include <hip/hip_runtime.h>
#include <cstdio>
#include <cstdint>
#include <cmath>

#ifndef MK_PER_PHASE
#define MK_PER_PHASE 0
#endif
#ifndef PROBE_DUP
#define PROBE_DUP 0
#endif
#define DUP(id) (((PROBE_DUP) >> (id)) & 1)

#define LAS __attribute__((address_space(3)))
#define GAS __attribute__((address_space(1)))
typedef unsigned short bf16_t;
typedef short bf16x8 __attribute__((ext_vector_type(8)));
typedef short s16x4 __attribute__((ext_vector_type(4)));
typedef float f32x4 __attribute__((ext_vector_type(4)));
typedef float f32x2 __attribute__((ext_vector_type(2)));
typedef float f32x16 __attribute__((ext_vector_type(16)));
typedef unsigned u32x4 __attribute__((ext_vector_type(4)));
typedef unsigned u32x2 __attribute__((ext_vector_type(2)));
typedef _Float16 h16x2 __attribute__((ext_vector_type(2)));
typedef GAS bf16_t gbf16;
typedef GAS float gf32;
typedef GAS unsigned char gu8;

constexpr int D = 2048, DEPTH = 2, DFF = 5632, NIN = 11264, NMOD = 9, NB = 6;
constexpr int MP = 8192, MS = 32768, M = MP + MS;
constexpr int NHQ = 16, NHKV = 4, HD = 128, KVW = NHKV * HD;
constexpr int OFF_Q = 0, OFF_K = 2048, OFF_V = 2560, OFF_U = 3072, OFF_SV = 5120, OFF_GA = 7168, OFF_GB = 9216;
constexpr int ZQ = 0, ZU = 2048, ZSV = 4096, ZGA = 6144, ZGB = 8192, ZK = 10240, ZV = 10752;
constexpr size_t ZB_Q = 0, ZB_U = (size_t)M * D, ZB_SV = 2 * (size_t)M * D, ZB_GA = 3 * (size_t)M * D, ZB_GB = 4 * (size_t)M * D, ZB_K = 5 * (size_t)M * D, ZB_V = ZB_K + (size_t)M * KVW;
constexpr float LN_EPS = 1e-5f;
constexpr float DN_ALPHA = 1.4142135623730951f;

constexpr size_t MiB = 1u << 20;
constexpr size_t WS_CTL = 0, CTL_ZERO_BYTES = 1 * MiB;
constexpr size_t WS_MOD = 1 * MiB;
constexpr size_t WS_COS = 2 * MiB, WS_SIN = 4 * MiB;
constexpr size_t WS_SW = 6 * MiB;
constexpr size_t WS_ST = 7 * MiB;
constexpr size_t WS_RS = 7 * MiB + 512 * 1024;
constexpr size_t WS_WT = 8 * MiB;
constexpr size_t WT_FFN1_IN = 0, WT_FFN1_OUT = 44 * MiB, WT_MIX_IN = 66 * MiB, WT_BRA = 110 * MiB, WT_BRS = 118 * MiB, WT_MO = 126 * MiB,
                 WT_FFN2_IN = 134 * MiB, WT_FFN2_OUT = 178 * MiB, WT_END = 200 * MiB;
constexpr size_t WS_H = WS_WT + WT_END;
constexpr size_t WS_Z = WS_H + 160 * MiB;
constexpr size_t WS_Y = WS_Z + 880 * MiB;
constexpr size_t WS_END = WS_Y + 160 * MiB;
static_assert(WT_BRS == WT_BRA + 8 * MiB && ZB_U == ZB_Q + (size_t)M * D && (size_t)M * D * 2 == 160 * MiB && (size_t)M * NIN * 2 == 880 * MiB && (size_t)NIN * D * 2 == 44 * MiB && (size_t)D * DFF * 2 == 22 * MiB && (size_t)M * 8 <= MiB, "ws map");
constexpr int CW_BAR = 4096;

constexpr int LDS_BYTES = 147456;
constexpr int MISC_OFF = 131072 + 8192;

__device__ __forceinline__ unsigned cvt_pk_bf16(float lo, float hi) { unsigned r; asm volatile("v_cvt_pk_bf16_f32 %0, %1, %2" : "=v"(r) : "v"(lo), "v"(hi)); return r; }
__device__ __forceinline__ unsigned pk_f16(float lo, float hi) { const h16x2 h = {(_Float16)lo, (_Float16)hi}; return __builtin_bit_cast(unsigned, h); }
__device__ __forceinline__ float f16lo(unsigned w) { return (float)__builtin_bit_cast(h16x2, w)[0]; }
__device__ __forceinline__ float f16hi(unsigned w) { return (float)__builtin_bit_cast(h16x2, w)[1]; }
__device__ __forceinline__ float bflo(unsigned w) { return __uint_as_float(w << 16); }
__device__ __forceinline__ float bfhi(unsigned w) { return __uint_as_float(w & 0xffff0000u); }
template <int XM> __device__ __forceinline__ float swz_xor(float v) { return __int_as_float(__builtin_amdgcn_ds_swizzle(__float_as_int(v), (XM << 10) | 0x1F)); }
__device__ __forceinline__ float wave_sum(float v) {
    v += swz_xor<1>(v); v += swz_xor<2>(v); v += swz_xor<4>(v); v += swz_xor<8>(v); v += swz_xor<16>(v);
    auto rr = __builtin_amdgcn_permlane32_swap(__float_as_uint(v), __float_as_uint(v), false, false);
    return __uint_as_float(rr[0]) + __uint_as_float(rr[1]);
}
__device__ __forceinline__ int wg_wave_index() { return __builtin_amdgcn_readfirstlane((int)(threadIdx.x >> 6)); }
__device__ __forceinline__ int make_tid(int wave_s) { int l; asm volatile("v_mbcnt_lo_u32_b32 %0, -1, 0\n\tv_mbcnt_hi_u32_b32 %0, -1, %0" : "=v"(l)); return wave_s * 64 + l; }
__device__ __forceinline__ float fast_exp2(float x) { return __builtin_amdgcn_exp2f(x); }
__device__ __forceinline__ float fast_rcp(float x) { return __builtin_amdgcn_rcpf(x); }
__device__ __forceinline__ float silu_f(float x) { return x * fast_rcp(1.0f + fast_exp2(-1.4426950408889634f * x)); }
__device__ __forceinline__ float sigmoid_f(float x) { return fast_rcp(1.0f + fast_exp2(-1.4426950408889634f * x)); }
__device__ __forceinline__ float gelu_tanh_f(float x) {
    const float x2 = x * x, p = fmaf(x2, -2.0f * 1.4426950408889634f * 0.7978845608028654f * 0.044715f, -2.0f * 1.4426950408889634f * 0.7978845608028654f);
    return x * fast_rcp(1.0f + fast_exp2(x * p));
}
__device__ __forceinline__ int batch_of(int row) { return row < MP ? (row >> 12) : 2 + ((row - MP) >> 13); }
__device__ __forceinline__ int pos_of(int row) { return row < MP ? (row & 4095) : (row & 8191); }
__host__ __device__ __forceinline__ int dperm(int p) { return 16 * (p >> 5) + 4 * ((p >> 3) & 3) + (p & 3) + 64 * ((p >> 2) & 1); }

namespace pg8 {
constexpr int BM = 256, BK = 64, HALF = 128, HTB = HALF * BK * 2, STAGE_BYTES = 8 * HTB, NXCD = 8, WGM = 8;
__host__ __device__ __forceinline__ int lds_byte(int r, int c) { const int st = (r >> 4) * 2 + (c >> 5), rr = r & 15, cc = c & 31, ob = rr * 64 + cc * 2; return st * 1024 + (ob ^ (((ob >> 9) & 1) << 5)); }
__host__ __device__ __forceinline__ void stage_rc(int b, int& R, int& C) { const int st = b / 1024, sb = b % 1024, swz = sb ^ (((sb >> 9) & 1) << 5); R = (st >> 1) * 16 + swz / 64; C = (st & 1) * 32 + (swz % 64) / 2; }
__host__ __device__ __forceinline__ int perm32(int rho) { const int n = rho >> 4, i = rho & 15; return 8 * (i >> 2) + 4 * n + (i & 3); }
struct Unit { int pm, pn; };
struct Gemm { const gbf16* A; const gbf16* Bt; };
template <int N_> struct StaticOrder {
    static constexpr int nM = M / BM, nN = N_ / BM, nwg = nM * nN;
    static constexpr int WG = (nN == 8) ? 4 : WGM;
    int G, c, rev;
    __host__ __device__ void init(int G_, int c_, int rev_ = 0) { G = G_; c = c_; rev = rev_; }
    __host__ __device__ bool next(int i, Unit& u) const {
        const long L = (long)i * G + c; if (L >= nwg) return false;
        int wgid = (int)L; { const int q = nwg / NXCD, r = nwg % NXCD, xcd = wgid % NXCD, off = wgid / NXCD; wgid = (xcd < r ? xcd * (q + 1) : r * (q + 1) + (xcd - r) * q) + off; }
        const int nig = WG * nN, gid = wgid / nig, fm = gid * WG, gsz = (nM - fm) < WG ? (nM - fm) : WG;
        u.pm = fm + ((wgid % nig) % gsz); u.pn = (wgid % nig) / gsz; if (rev) u.pm = nM - 1 - u.pm; return true;
    }
};

template <class Epi, int N, int K, int lda, bool ALIGN_EPI, bool SP2, int ldb = K, int KSA = BK * 2, int KSB = BK * 2, int TJ = 0, size_t JUMPA = 0>
__device__ __forceinline__ void gemm_phase(LAS unsigned char* lds, const Gemm g, const StaticOrder<N>& S, const Epi& E, int wave_s) {
    const int tid = make_tid(wave_s), wid = __builtin_amdgcn_readfirstlane(tid >> 6), lane = tid & 63, wr = wid >> 2, wc = wid & 3, fr = lane & 15, fq = lane >> 4;
    constexpr int nt = K / BK;
    unsigned voffA[2], voffB[2];
#pragma unroll
    for (int i = 0; i < 2; ++i) { int R, C; stage_rc(tid * 16 + i * 8192, R, C); const int Rb = Epi::PERM ? ((R & ~31) + perm32(R & 31)) : R;
        voffA[i] = (unsigned)(R * lda + C) * 2u; voffB[i] = (unsigned)(Rb * ldb + C) * 2u; }
    constexpr size_t kstepA = (size_t)KSA, kstepB = (size_t)KSB;
    constexpr size_t hstepA = (size_t)HALF * lda * 2, hstepB = (size_t)HALF * ldb * 2;
    constexpr size_t tstepA = (KSA == BK * 2) ? 2 * hstepA : (size_t)(K / BK) * KSA, tstepB = (KSB == BK * 2) ? 2 * hstepB : (size_t)(K / BK) * KSB;
    const unsigned ldsw = (unsigned)wid * 1024u;
    const int aoff = lds_byte(wr * 64 + fr, fq * 8), boff = lds_byte(wc * 32 + fr, fq * 8);
#define PG8_SA(b, h) (((b) * 2 + (h)) * HTB)
#define PG8_SB(b, h) ((4 + (b) * 2 + (h)) * HTB)
#define PG8_STAGE(bufoff, gbase, voff) do { _Pragma("unroll") for (int _i = 0; _i < 2; ++_i) \
        __builtin_amdgcn_global_load_lds((const GAS unsigned*)((const GAS char*)(gbase) + (voff)[_i]), (LAS unsigned*)(lds + (bufoff) + ldsw + _i * 8192), 16, 0, 0); } while (0)
#define PG8_LDA(dst, b, h) do { _Pragma("unroll") for (int m = 0; m < 4; ++m) _Pragma("unroll") for (int k = 0; k < 2; ++k) dst[m][k] = *(const LAS bf16x8*)(lds + PG8_SA(b, h) + aoff + m * 2048 + k * 1024); } while (0)
#define PG8_LDB(dst, b, h) do { _Pragma("unroll") for (int n = 0; n < 2; ++n) _Pragma("unroll") for (int k = 0; k < 2; ++k) dst[n][k] = *(const LAS bf16x8*)(lds + PG8_SB(b, h) + boff + n * 2048 + k * 1024); } while (0)
#define PG8_MMA(ai, bj, At, Bt) do { __builtin_amdgcn_s_setprio(1); _Pragma("unroll") for (int m = 0; m < 4; ++m) _Pragma("unroll") for (int n = 0; n < 2; ++n) _Pragma("unroll") for (int k = 0; k < 2; ++k) \
        acc[ai][bj][m][n] = __builtin_amdgcn_mfma_f32_16x16x32_bf16(Bt[n][k], At[m][k], acc[ai][bj][m][n], 0, 0, 0); __builtin_amdgcn_s_setprio(0); } while (0)
#define PG8_WAIT_V(n) asm volatile("s_waitcnt vmcnt(" #n ")" ::: "memory")
#define PG8_WAIT_L(n) asm volatile("s_waitcnt lgkmcnt(" #n ")" ::: "memory")
#define PG8_BAR __builtin_amdgcn_s_barrier()
#define PG8_SCHED __builtin_amdgcn_sched_barrier(0)
    Unit cur, nxt; int ui = 0;
    if (!S.next(0, cur)) return;
    f32x4 acc[2][2][4][2];
#pragma unroll
    for (int a = 0; a < 2; ++a)
#pragma unroll
        for (int b = 0; b < 2; ++b)
#pragma unroll
            for (int m = 0; m < 4; ++m)
#pragma unroll
                for (int n = 0; n < 2; ++n) acc[a][b][m][n] = (f32x4){0.f, 0.f, 0.f, 0.f};
    bf16x8 At[4][2], B0[2][2], B1[2][2];
    const GAS char* cA = (const GAS char*)g.A + (size_t)cur.pm * tstepA; const GAS char* cB = (const GAS char*)g.Bt + (size_t)cur.pn * tstepB;
    if constexpr (SP2) {
        PG8_STAGE(PG8_SB(0, 0), cB, voffB); PG8_STAGE(PG8_SB(0, 1), cB + hstepB, voffB); PG8_STAGE(PG8_SA(0, 0), cA, voffA); PG8_STAGE(PG8_SA(0, 1), cA + hstepA, voffA);
        if (wr == 1) PG8_BAR;
        PG8_WAIT_V(2); PG8_BAR;
        PG8_STAGE(PG8_SB(1, 0), cB + kstepB, voffB); PG8_STAGE(PG8_SA(1, 0), cA + kstepA, voffA); PG8_STAGE(PG8_SB(1, 1), cB + hstepB + kstepB, voffB);
        PG8_WAIT_V(6); PG8_BAR;
    } else {
        PG8_STAGE(PG8_SB(0, 0), cB, voffB); PG8_STAGE(PG8_SA(0, 0), cA, voffA); PG8_STAGE(PG8_SB(0, 1), cB + hstepB, voffB); PG8_STAGE(PG8_SA(0, 1), cA + hstepA, voffA);
        if (wr == 1) PG8_BAR;
        PG8_WAIT_V(4); PG8_BAR;
        PG8_STAGE(PG8_SB(1, 0), cB + kstepB, voffB); PG8_STAGE(PG8_SA(1, 0), cA + kstepA, voffA); PG8_STAGE(PG8_SB(1, 1), cB + hstepB + kstepB, voffB);
        PG8_WAIT_V(6); PG8_BAR;
    }
    for (;;) {
        const bool has_next = S.next(ui + 1, nxt);
        const GAS char* nA = has_next ? (const GAS char*)g.A + (size_t)nxt.pm * tstepA : cA; const GAS char* nB = has_next ? (const GAS char*)g.Bt + (size_t)nxt.pn * tstepB : cB;
        for (int t = 0; t < nt; t += 2) {
            const bool last = (t == nt - 2);
            const size_t j1 = (TJ > 0 && t >= TJ) ? JUMPA : 0, j2 = (TJ > 0 && t + 2 >= TJ) ? JUMPA : 0;
            const GAS char* a1 = cA + (size_t)(t + 1) * kstepA + j1;
            const GAS char* a2 = last ? nA : cA + (size_t)(t + 2) * kstepA + j2; const GAS char* b2 = last ? nB : cB + (size_t)(t + 2) * kstepB;
            const GAS char* a3 = a2 + kstepA; const GAS char* b3 = b2 + kstepB;
            asm volatile("" : "+s"(a1), "+s"(a2), "+s"(b2), "+s"(a3), "+s"(b3), "+v"(voffA[0]), "+v"(voffA[1]), "+v"(voffB[0]), "+v"(voffB[1]));
            if constexpr (TJ > 0) { if (t == TJ) E.mid(acc, cur, wr, wc, fr, fq); }
            if constexpr (SP2) {
            PG8_LDB(B0, 0, 0); PG8_LDB(B1, 0, 1); PG8_SCHED; PG8_LDA(At, 0, 0); PG8_STAGE(PG8_SA(1, 1), a1 + hstepA, voffA);
            PG8_WAIT_V(8); PG8_WAIT_L(0); PG8_BAR; PG8_MMA(0, 0, At, B0); PG8_MMA(0, 1, At, B1); PG8_BAR; PG8_SCHED;
            PG8_LDA(At, 0, 1); PG8_STAGE(PG8_SB(0, 0), b2, voffB); PG8_STAGE(PG8_SB(0, 1), b2 + hstepB, voffB); PG8_STAGE(PG8_SA(0, 0), a2, voffA);
            PG8_WAIT_V(8); PG8_WAIT_L(0); PG8_BAR; PG8_MMA(1, 0, At, B0); PG8_MMA(1, 1, At, B1); PG8_BAR; PG8_SCHED;
            PG8_LDB(B0, 1, 0); PG8_LDB(B1, 1, 1); PG8_SCHED; PG8_LDA(At, 1, 0); PG8_STAGE(PG8_SA(0, 1), a2 + hstepA, voffA);
            PG8_WAIT_V(8); PG8_WAIT_L(0); PG8_BAR; PG8_MMA(0, 0, At, B0); PG8_MMA(0, 1, At, B1); PG8_BAR; PG8_SCHED;
            PG8_LDA(At, 1, 1); PG8_STAGE(PG8_SB(1, 0), b3, voffB); PG8_STAGE(PG8_SB(1, 1), b3 + hstepB, voffB); PG8_STAGE(PG8_SA(1, 0), a3, voffA);
            PG8_WAIT_V(8); PG8_WAIT_L(0); PG8_BAR; PG8_MMA(1, 0, At, B0); PG8_MMA(1, 1, At, B1); PG8_BAR; PG8_SCHED;
            } else {
            PG8_LDB(B0, 0, 0); PG8_SCHED; PG8_LDA(At, 0, 0); PG8_STAGE(PG8_SA(1, 1), a1 + hstepA, voffA);
            PG8_WAIT_L(8); PG8_BAR; PG8_WAIT_L(0); PG8_MMA(0, 0, At, B0); PG8_BAR; PG8_SCHED;
            PG8_LDB(B1, 0, 1); PG8_STAGE(PG8_SB(0, 0), b2, voffB);
            PG8_BAR; PG8_WAIT_L(0); PG8_MMA(0, 1, At, B1); PG8_BAR;
            PG8_LDA(At, 0, 1); PG8_STAGE(PG8_SA(0, 0), a2, voffA);
            PG8_BAR; PG8_WAIT_L(0); PG8_MMA(1, 0, At, B0); PG8_BAR; PG8_SCHED;
            PG8_STAGE(PG8_SB(0, 1), b2 + hstepB, voffB);
            PG8_WAIT_V(6); PG8_BAR; PG8_MMA(1, 1, At, B1); PG8_BAR;
            PG8_LDB(B0, 1, 0); PG8_SCHED; PG8_LDA(At, 1, 0); PG8_STAGE(PG8_SA(0, 1), a2 + hstepA, voffA);
            PG8_WAIT_L(8); PG8_BAR; PG8_WAIT_L(0); PG8_MMA(0, 0, At, B0); PG8_BAR; PG8_SCHED;
            PG8_LDB(B1, 1, 1); PG8_STAGE(PG8_SB(1, 0), b3, voffB);
            PG8_BAR; PG8_WAIT_L(0); PG8_MMA(0, 1, At, B1); PG8_BAR;
            PG8_LDA(At, 1, 1); PG8_STAGE(PG8_SA(1, 0), a3, voffA);
            PG8_BAR; PG8_WAIT_L(0); PG8_MMA(1, 0, At, B0); PG8_BAR; PG8_SCHED;
            PG8_STAGE(PG8_SB(1, 1), b3 + hstepB, voffB);
            PG8_WAIT_V(6); PG8_BAR; PG8_MMA(1, 1, At, B1); PG8_BAR;
            }
        }
        if constexpr (ALIGN_EPI) { if (wr == 0) PG8_BAR; }
        E(acc, cur, wr, wc, fr, fq);
        if (!has_next) break;
#pragma unroll
        for (int a = 0; a < 2; ++a)
#pragma unroll
            for (int b = 0; b < 2; ++b)
#pragma unroll
                for (int m = 0; m < 4; ++m)
#pragma unroll
                    for (int n = 0; n < 2; ++n) acc[a][b][m][n] = (f32x4){0.f, 0.f, 0.f, 0.f};
        cur = nxt; cA = nA; cB = nB; ++ui;
        if constexpr (ALIGN_EPI) { if (wr == 1) PG8_BAR; }
    }
    PG8_WAIT_V(0);
    if constexpr (!ALIGN_EPI) { if (wr == 0) PG8_BAR; }
    PG8_BAR;
#undef PG8_SA
#undef PG8_SB
#undef PG8_STAGE
#undef PG8_LDA
#undef PG8_LDB
#undef PG8_MMA
#undef PG8_WAIT_V
#undef PG8_WAIT_L
#undef PG8_BAR
#undef PG8_SCHED
}

struct EpiNone {
    static constexpr bool PERM = true;
    __device__ __forceinline__ void operator()(const f32x4 (&acc)[2][2][4][2], const Unit&, int, int, int, int) const {
#pragma unroll
        for (int a = 0; a < 2; ++a)
#pragma unroll
            for (int b = 0; b < 2; ++b)
#pragma unroll
                for (int m = 0; m < 4; ++m)
#pragma unroll
                    for (int n = 0; n < 2; ++n) asm volatile("" :: "v"(acc[a][b][m][n]));
    }
};
struct EpiSwiglu {
    static constexpr bool PERM = true;
    gbf16* O;
    __device__ __forceinline__ void operator()(const f32x4 (&acc)[2][2][4][2], const Unit& u, int wr, int wc, int fr, int fq) const {
        const int row0 = u.pm * BM + wr * 64 + fr, col0 = u.pn * HALF + wc * 32 + 8 * fq;
#pragma unroll
        for (int ai = 0; ai < 2; ++ai)
#pragma unroll
            for (int m = 0; m < 4; ++m) {
                gbf16* rowp = O + (size_t)(row0 + ai * HALF + m * 16) * DFF + col0;
                const f32x4 g0 = acc[ai][0][m][0], g1 = acc[ai][0][m][1], u0 = acc[ai][1][m][0], u1 = acc[ai][1][m][1];
                u32x4 w;
#define SWG(g_, u_) ((g_) * (u_) * fast_rcp(1.0f + fast_exp2(-(g_))))
                w.x = cvt_pk_bf16(SWG(g0[0], u0[0]), SWG(g0[1], u0[1])); w.y = cvt_pk_bf16(SWG(g0[2], u0[2]), SWG(g0[3], u0[3]));
                w.z = cvt_pk_bf16(SWG(g1[0], u1[0]), SWG(g1[1], u1[1])); w.w = cvt_pk_bf16(SWG(g1[2], u1[2]), SWG(g1[3], u1[3]));
#undef SWG
                *(GAS u32x4*)rowp = w;
            }
    }
};
template <int LNF> struct EpiResid {
    static constexpr bool PERM = true; static constexpr int ln = LNF;
    const gf32* xsrc_p; const gf32* xsrc_s;
    GAS unsigned short* Y;
    const gf32* gate;
    const gf32* rs; const gf32* lng; const gf32* lnb;
    float wgt;
    __device__ __forceinline__ void operator()(const f32x4 (&acc)[2][2][4][2], const Unit& u, int wr, int wc, int fr, int fq) const {
        const int rowt = u.pm * BM, row0 = rowt + wr * 64 + fr, col0 = u.pn * BM + wc * 32 + 8 * fq;
        const int b = batch_of(rowt);
        const gf32* gp = gate + (size_t)b * NMOD * D + col0;
#pragma unroll
        for (int ai = 0; ai < 2; ++ai) {
            f32x2 st[4];
#pragma unroll
            for (int m = 0; m < 4; ++m) { st[m] = (f32x2){0.f, 1.f}; if (ln) st[m] = *(const GAS f32x2*)(rs + 2 * (size_t)(row0 + ai * HALF + m * 16)); }
#pragma unroll
            for (int bj = 0; bj < 2; ++bj) {
                const int co = bj * HALF;
                u32x4 yw[4]; u32x2 pk[4];
                if (ln) {
#pragma unroll
                    for (int m = 0; m < 4; ++m) yw[m] = *(const GAS u32x4*)(Y + (size_t)(row0 + ai * HALF + m * 16) * D + col0 + co);
                }
#pragma unroll
                for (int n = 0; n < 2; ++n) {
                    const f32x4 gv = *(const GAS f32x4*)(gp + co + 4 * n) * wgt;
                    f32x4 ga = (f32x4){DN_ALPHA, DN_ALPHA, DN_ALPHA, DN_ALPHA}, ba = (f32x4){0.f, 0.f, 0.f, 0.f};
                    if (ln) { ga = *(const GAS f32x4*)(lng + col0 + co + 4 * n) * DN_ALPHA; ba = *(const GAS f32x4*)(lnb + col0 + co + 4 * n) * DN_ALPHA; }
                    f32x4 xv[4];
                    if (ln) {
#pragma unroll
                        for (int m = 0; m < 4; ++m) { const unsigned w0 = n ? yw[m].z : yw[m].x, w1 = n ? yw[m].w : yw[m].y; xv[m] = (f32x4){f16lo(w0), f16hi(w0), f16lo(w1), f16hi(w1)}; }
                    } else {
                        const gf32* xs = (rowt < MP) ? xsrc_p + (size_t)row0 * D : xsrc_s + (size_t)(row0 - MP) * D;
#pragma unroll
                        for (int m = 0; m < 4; ++m) xv[m] = *(const GAS f32x4*)(xs + (size_t)(ai * HALF + m * 16) * D + col0 + co + 4 * n);
                    }
#pragma unroll
                    for (int m = 0; m < 4; ++m) {
                        const f32x4 o = (xv[m] - st[m].x) * st[m].y * ga + ba + gv * acc[ai][bj][m][n];
                        const u32x2 p2 = {pk_f16(o[0], o[1]), pk_f16(o[2], o[3])};
                        if (n == 0) pk[m] = p2;
                        else *(GAS u32x4*)(Y + (size_t)(row0 + ai * HALF + m * 16) * D + col0 + co) = (u32x4){pk[m].x, pk[m].y, p2.x, p2.y};
                    }
                }
            }
        }
    }
};
struct EpiMix {
    static constexpr bool PERM = true;
    gbf16* Z; const gf32* cosT; const gf32* sinT; gf32* SP;
    __device__ __forceinline__ void operator()(const f32x4 (&acc)[2][2][4][2], const Unit& u, int wr, int wc, int fr, int fq) const {
        const int pn = u.pn, row0 = u.pm * BM + wr * 64 + fr;
        const int reg = pn < 40 ? (pn >> 3) : 5 + ((pn - 40) >> 1);
        const int ld = pn < 40 ? D : KVW;
        const int colt = pn < 40 ? (pn & 7) * BM : ((pn - 40) & 1) * BM;
        const size_t roff = pn < 40 ? (size_t)reg * ((size_t)M * D) : ZB_K + (size_t)(reg - 5) * ((size_t)M * KVW);
        gbf16* base = Z + roff + colt + wc * 32 + 8 * fq;
        const int kind = (reg == 0 || reg == 5) ? 0 : (reg <= 2 ? 1 : (reg <= 4 ? 2 : 3));
        if (kind == 0) {
#pragma unroll
            for (int ai = 0; ai < 2; ++ai) {
                f32x4 c4[4], s4[4];
#pragma unroll
                for (int m = 0; m < 4; ++m) { const int pos = pos_of(row0 + ai * HALF + m * 16);
                    c4[m] = *(const GAS f32x4*)(cosT + (size_t)pos * 64 + wc * 16 + fq * 4); s4[m] = *(const GAS f32x4*)(sinT + (size_t)pos * 64 + wc * 16 + fq * 4); }
#pragma unroll
                for (int m = 0; m < 4; ++m) { gbf16* rowp = base + (size_t)(row0 + ai * HALF + m * 16) * ld;
#pragma unroll
                    for (int bj = 0; bj < 2; ++bj) { const f32x4 x1 = acc[ai][bj][m][0], x2 = acc[ai][bj][m][1];
                        const f32x4 o1 = x1 * c4[m] - x2 * s4[m], o2 = x2 * c4[m] + x1 * s4[m];
                        u32x4 w; w.x = cvt_pk_bf16(o1[0], o1[1]); w.y = cvt_pk_bf16(o1[2], o1[3]); w.z = cvt_pk_bf16(o2[0], o2[1]); w.w = cvt_pk_bf16(o2[2], o2[3]);
                        *(GAS u32x4*)(rowp + bj * HALF) = w; } }
            }
        } else {
#pragma unroll
            for (int ai = 0; ai < 2; ++ai)
#pragma unroll
                for (int m = 0; m < 4; ++m) { gbf16* rowp = base + (size_t)(row0 + ai * HALF + m * 16) * ld;
                    float rs_ = 0.f, rq_ = 0.f;
#pragma unroll
                    for (int bj = 0; bj < 2; ++bj) { f32x4 v0 = acc[ai][bj][m][0], v1 = acc[ai][bj][m][1];
                        if (kind == 1) {
#pragma unroll
                            for (int j = 0; j < 4; ++j) { v0[j] = gelu_tanh_f(v0[j]); v1[j] = gelu_tanh_f(v1[j]); }
                            if (reg == 2) {
#pragma unroll
                                for (int j = 0; j < 4; ++j) { rs_ += v0[j] + v1[j]; rq_ += v0[j] * v0[j] + v1[j] * v1[j]; } }
                        } else if (kind == 2) {
#pragma unroll
                            for (int j = 0; j < 4; ++j) { v0[j] = fast_rcp(1.0f + fast_exp2(-v0[j])); v1[j] = fast_rcp(1.0f + fast_exp2(-v1[j])); }
                        }
                        u32x4 w; w.x = cvt_pk_bf16(v0[0], v0[1]); w.y = cvt_pk_bf16(v0[2], v0[3]); w.z = cvt_pk_bf16(v1[0], v1[1]); w.w = cvt_pk_bf16(v1[2], v1[3]);
                        *(GAS u32x4*)(rowp + bj * HALF) = w; }
                    if (reg == 2) {
                        rs_ += swz_xor<16>(rs_); rq_ += swz_xor<16>(rq_);
                        { auto r1 = __builtin_amdgcn_permlane32_swap(__float_as_uint(rs_), __float_as_uint(rs_), false, false); rs_ = __uint_as_float(r1[0]) + __uint_as_float(r1[1]);
                          auto r2 = __builtin_amdgcn_permlane32_swap(__float_as_uint(rq_), __float_as_uint(rq_), false, false); rq_ = __uint_as_float(r2[0]) + __uint_as_float(r2[1]); }
                        if (fq == 0) *(GAS f32x2*)(SP + ((size_t)(row0 + ai * HALF + m * 16) * 32 + (pn - 16) * 4 + wc) * 2) = (f32x2){rs_, rq_}; } }
        }
    }
};
struct EpiBranchF {
    static constexpr bool PERM = true;
    gbf16* O; const gbf16* Ga; const gbf16* Gb;
    __device__ __forceinline__ void mid(f32x4 (&acc)[2][2][4][2], const Unit& u, int wr, int wc, int fr, int fq) const {
        const gbf16* Ga = this->Ga; const gbf16* Gb = this->Gb; int rowl = wr * 64 + fr;
        asm volatile("" : "+s"(Ga), "+s"(Gb), "+v"(rowl));
        const int row0 = u.pm * BM + rowl, col0 = u.pn * BM + wc * 32 + 8 * fq;
#pragma unroll
        for (int ai = 0; ai < 2; ++ai)
#pragma unroll
            for (int mp = 0; mp < 2; ++mp) {
                u32x4 ga[2][2], gb[2][2];
#pragma unroll
                for (int mm = 0; mm < 2; ++mm)
#pragma unroll
                    for (int bj = 0; bj < 2; ++bj) { const size_t o = (size_t)(row0 + ai * HALF + (2 * mp + mm) * 16) * D + col0 + bj * HALF; ga[mm][bj] = *(const GAS u32x4*)(Ga + o); gb[mm][bj] = *(const GAS u32x4*)(Gb + o); }
#pragma unroll
                for (int mm = 0; mm < 2; ++mm)
#pragma unroll
                    for (int bj = 0; bj < 2; ++bj) { const u32x4 a4 = ga[mm][bj], b4 = gb[mm][bj]; const int m = 2 * mp + mm;
                        const float sa[8] = { bflo(a4.x), bfhi(a4.x), bflo(a4.y), bfhi(a4.y), bflo(a4.z), bfhi(a4.z), bflo(a4.w), bfhi(a4.w) };
                        const float sb[8] = { bflo(b4.x), bfhi(b4.x), bflo(b4.y), bfhi(b4.y), bflo(b4.z), bfhi(b4.z), bflo(b4.w), bfhi(b4.w) };
#pragma unroll
                        for (int j = 0; j < 4; ++j) { acc[ai][bj][m][0][j] *= sa[j] * fast_rcp(fmaxf(sb[j], 8.673617379884035e-19f)); acc[ai][bj][m][1][j] *= sa[4 + j] * fast_rcp(fmaxf(sb[4 + j], 8.673617379884035e-19f)); } }
            }
    }
    __device__ __forceinline__ void operator()(const f32x4 (&acc)[2][2][4][2], const Unit& u, int wr, int wc, int fr, int fq) const {
        const int row0 = u.pm * BM + wr * 64 + fr, col0 = u.pn * BM + wc * 32 + 8 * fq;
#pragma unroll
        for (int ai = 0; ai < 2; ++ai) {
            u32x4 gb[4][2];
#pragma unroll
            for (int m = 0; m < 4; ++m)
#pragma unroll
                for (int bj = 0; bj < 2; ++bj) gb[m][bj] = *(const GAS u32x4*)(Gb + (size_t)(row0 + ai * HALF + m * 16) * D + col0 + bj * HALF);
#pragma unroll
            for (int m = 0; m < 4; ++m)
#pragma unroll
                for (int bj = 0; bj < 2; ++bj) { const u32x4 b4 = gb[m][bj]; const f32x4 v0 = acc[ai][bj][m][0], v1 = acc[ai][bj][m][1];
                    const float sb[8] = { bflo(b4.x), bfhi(b4.x), bflo(b4.y), bfhi(b4.y), bflo(b4.z), bfhi(b4.z), bflo(b4.w), bfhi(b4.w) };
                    float r[8];
#pragma unroll
                    for (int j = 0; j < 4; ++j) { r[j] = v0[j] * fmaxf(sb[j], 8.673617379884035e-19f); r[4 + j] = v1[j] * fmaxf(sb[4 + j], 8.673617379884035e-19f); }
                    u32x4 w; w.x = cvt_pk_bf16(r[0], r[1]); w.y = cvt_pk_bf16(r[2], r[3]); w.z = cvt_pk_bf16(r[4], r[5]); w.w = cvt_pk_bf16(r[6], r[7]);
                    *(GAS u32x4*)(O + (size_t)(row0 + ai * HALF + m * 16) * D + col0 + bj * HALF) = w; }
        }
    }
};
}

namespace att {
constexpr int KVBLK = 64, NW = 8, QBLK = 32;
constexpr float SCALE = 0.088388347648318440f;
constexpr float THR = 8.f;
#ifndef ATT_SDEPTH
#define ATT_SDEPTH 1
#endif
constexpr int SDEPTH = ATT_SDEPTH;
constexpr int SHM_V = KVBLK * HD * 2, SHM_K = KVBLK * HD * 2;
#define KSWZ(row, colB) ((row) * 256 + ((colB) ^ (((row) & 7) << 4)))
#define SBAR() __builtin_amdgcn_sched_barrier(0)
__device__ __forceinline__ int crow(int r, int hi) { return (r & 3) + 8 * (r >> 2) + 4 * hi; }
__device__ __forceinline__ void partialSM(f32x16& p0, f32x16& p1, float& m_reg, float& mn, float& alpha) {
  constexpr float C = SCALE * 1.4426950408889634f;
  float pmax = p0[0];
#pragma unroll
  for (int r = 1; r < 16; ++r) pmax = fmaxf(pmax, p0[r]);
#pragma unroll
  for (int r = 0; r < 16; ++r) pmax = fmaxf(pmax, p1[r]);
  { auto rr = __builtin_amdgcn_permlane32_swap(__float_as_uint(pmax), __float_as_uint(pmax), false, false);
    pmax = fmaxf(__uint_as_float(rr[0]), __uint_as_float(rr[1])); }
  if (__builtin_expect(__all(pmax - m_reg <= THR / SCALE), 1)) { mn = m_reg; alpha = 1.f; }
  else { mn = fmaxf(m_reg, pmax); alpha = __builtin_amdgcn_exp2f((m_reg - mn) * C); m_reg = mn; }
  float mnC = -mn * C;
#pragma unroll
  for (int r = 0; r < 16; ++r) p0[r] = fmaf(p0[r], C, mnC);
#pragma unroll
  for (int r = 0; r < 16; ++r) p1[r] = fmaf(p1[r], C, mnC);
#pragma unroll
  for (int r = 0; r < 16; ++r) p0[r] = __builtin_amdgcn_exp2f(p0[r]);
}
__device__ __forceinline__ void finishSM(f32x16& p0, f32x16& p1, float alpha, float& l_reg, bf16x8& pa0, bf16x8& pa1, bf16x8& pa2, bf16x8& pa3) {
#pragma unroll
  for (int r = 0; r < 16; ++r) p1[r] = __builtin_amdgcn_exp2f(p1[r]);
  float ps = 0;
#pragma unroll
  for (int r = 0; r < 16; ++r) ps += p0[r];
#pragma unroll
  for (int r = 0; r < 16; ++r) ps += p1[r];
  { auto rr = __builtin_amdgcn_permlane32_swap(__float_as_uint(ps), __float_as_uint(ps), false, false);
    ps = __uint_as_float(rr[0]) + __uint_as_float(rr[1]); }
  l_reg = l_reg * alpha + ps;
#define PK4(P, BASE, OUT) do { unsigned a0 = cvt_pk_bf16(P[BASE + 0], P[BASE + 1]), a1 = cvt_pk_bf16(P[BASE + 2], P[BASE + 3]);   \
    unsigned b0 = cvt_pk_bf16(P[BASE + 4], P[BASE + 5]), b1 = cvt_pk_bf16(P[BASE + 6], P[BASE + 7]);                              \
    auto r0 = __builtin_amdgcn_permlane32_swap(a0, b0, false, false); auto r1 = __builtin_amdgcn_permlane32_swap(a1, b1, false, false); \
    u32x4 w = {r0[0], r1[0], r0[1], r1[1]}; OUT = *reinterpret_cast<bf16x8*>(&w); } while (0)
  PK4(p0, 0, pa0); PK4(p0, 8, pa1); PK4(p1, 0, pa2); PK4(p1, 8, pa3);
#undef PK4
}
__device__ __forceinline__ void qkt(f32x16& p0, f32x16& p1, const LAS char* Ks, const bf16x8* qr, int r32, int hi) {
  p0 = f32x16{}; p1 = f32x16{};
#pragma unroll
  for (int d0 = 0; d0 < 8; ++d0) { int cb = (d0 * 16 + hi * 8) * 2;
    bf16x8 b0 = *(const LAS bf16x8*)(Ks + KSWZ(r32, cb));
    bf16x8 b1 = *(const LAS bf16x8*)(Ks + KSWZ(32 + r32, cb));
    p0 = __builtin_amdgcn_mfma_f32_32x32x16_bf16(b0, qr[d0], p0, 0, 0, 0);
    p1 = __builtin_amdgcn_mfma_f32_32x32x16_bf16(b1, qr[d0], p1, 0, 0, 0); }
}
__device__ __forceinline__ void band_mask(f32x16& p0, f32x16& p1, int ktp, int q, int hi) {
  const float ninf = -__builtin_inff();
  if (ktp < 2) { const int kb = 64 * ktp - 128, lim = q - 128;
#pragma unroll
    for (int r = 0; r < 16; ++r) { const int k = kb + crow(r, hi); if (k < lim) p0[r] = ninf; if (k + 32 < lim) p1[r] = ninf; }
  } else if (ktp >= 4) { const int kb = 64 * ktp - 128, lim = q + 128;
#pragma unroll
    for (int r = 0; r < 16; ++r) { const int k = kb + crow(r, hi); if (k > lim) p0[r] = ninf; if (k + 32 > lim) p1[r] = ninf; }
  }
}
__device__ __forceinline__ int v_st(int k, int c) { const int kk = (k & ~0xC) | ((k & 4) << 1) | ((k & 8) >> 1); return ((kk >> 3) * 4 + (c >> 5)) * 512 + ((kk & 7) * 32 + (c & 31)) * 2; }
__device__ __forceinline__ int v_rd_base(int lane) { return ((lane & 3) << 3) | (((lane >> 2) & 3) << 6) | (((lane >> 4) & 1) << 5) | (((lane >> 5) & 1) << 8); }
constexpr int v_rd_off(int d0, int ks, int half) { return d0 * 512 + ks * 4096 + half * 2048; }
template <int OFF> __device__ __forceinline__ s16x4 tr_read(int vb) {
  s16x4 r; asm volatile("ds_read_b64_tr_b16 %0, %1 offset:%2" : "=&v"(r) : "v"(vb), "i"(OFF) : "memory"); return r;
}
template <int D0> __device__ __forceinline__ void pv_one(f32x16& od, int vb, bf16x8 pa0, bf16x8 pa1, bf16x8 pa2, bf16x8 pa3) {
  const s16x4 l0 = tr_read<v_rd_off(D0, 0, 0)>(vb), h0 = tr_read<v_rd_off(D0, 0, 1)>(vb), l1 = tr_read<v_rd_off(D0, 1, 0)>(vb), h1 = tr_read<v_rd_off(D0, 1, 1)>(vb);
  const s16x4 l2 = tr_read<v_rd_off(D0, 2, 0)>(vb), h2 = tr_read<v_rd_off(D0, 2, 1)>(vb), l3 = tr_read<v_rd_off(D0, 3, 0)>(vb), h3 = tr_read<v_rd_off(D0, 3, 1)>(vb);
  asm volatile("s_waitcnt lgkmcnt(0)" ::: "memory"); SBAR();
#define PK(L, H) (bf16x8){L[0], L[1], L[2], L[3], H[0], H[1], H[2], H[3]}
  od = __builtin_amdgcn_mfma_f32_32x32x16_bf16(pa0, PK(l0, h0), od, 0, 0, 0);
  od = __builtin_amdgcn_mfma_f32_32x32x16_bf16(pa1, PK(l1, h1), od, 0, 0, 0);
  od = __builtin_amdgcn_mfma_f32_32x32x16_bf16(pa2, PK(l2, h2), od, 0, 0, 0);
  od = __builtin_amdgcn_mfma_f32_32x32x16_bf16(pa3, PK(l3, h3), od, 0, 0, 0);
#undef PK
}
__device__ __forceinline__ void pv_d0(f32x16* o, int vb, bf16x8 pa0, bf16x8 pa1, bf16x8 pa2, bf16x8 pa3) {
  pv_one<0>(o[0], vb, pa0, pa1, pa2, pa3); pv_one<1>(o[1], vb, pa0, pa1, pa2, pa3); pv_one<2>(o[2], vb, pa0, pa1, pa2, pa3); pv_one<3>(o[3], vb, pa0, pa1, pa2, pa3);
}

__device__ __forceinline__ void attn_unit(gbf16* Zq, gbf16* Oq, const gbf16* Zk, const gbf16* Zv, int seq_row0, int nb, int nblk, int g, int hp, const gf32* sink16, LAS char* lds, int wave_s) {
  const int tid = make_tid(wave_s), wid = __builtin_amdgcn_readfirstlane(tid >> 6), lane = tid & 63, r32 = lane & 31, hi = lane >> 5;
  LAS char* V_lds = lds; LAS char* K_lds = lds + 2 * SHM_V;
  LAS float* ws = (LAS float*)(lds + 2 * SHM_V + 2 * SHM_K) + wid * 64; LAS float* li_l = ws; LAS float* al_l = ws + 32;
  float m_reg = -1e30f, l_reg = 0; f32x16 o[4] = {}; bf16x8 qr[8];
  const int qsub = (wid & 3) ^ ((wid >> 2) << 1);
  const int hq = 4 * g + 2 * hp + (wid >> 2), qrel0 = 32 * qsub, qi = qrel0 + r32;
#define SKIPT(t) (((t) == 0 && qsub >= 2) || ((t) == 5 && qsub < 2))
#define MASKT(t) (((t) == 0 && qsub < 2) || ((t) == 1 && qsub >= 2) || ((t) == 4 && qsub < 2) || ((t) == 5 && qsub >= 2))
  const int blk_row0 = seq_row0 + 128 * nb;
  const gbf16* Qw = Zq + (size_t)(blk_row0 + qi) * D + hq * HD + hi * 8;
#pragma unroll
  for (int d0 = 0; d0 < 8; ++d0) qr[d0] = *(const GAS bf16x8*)(Qw + d0 * 16);
  const int kt_lo = (nb == 0) ? 2 : 0, kt_hi = (nb == nblk - 1) ? 4 : 6, NT = kt_hi - kt_lo;
  const gbf16* Kh = Zk + (size_t)(blk_row0 - 128 + 64 * kt_lo) * KVW + g * HD;
  const gbf16* Vh = Zv + (size_t)(blk_row0 - 128 + 64 * kt_lo) * KVW + g * HD;
  const int sr = tid >> 4, sc = (tid & 15) * 8, vst0 = v_st(sr, sc), vst1 = v_st(32 + sr, sc);
  const int vb0 = (int)(uintptr_t)V_lds + v_rd_base(lane);
  struct { bf16x8 vs0, vs1, ks0, ks1; } sr_[SDEPTH];
#define SLOAD(i, k0) do { sr_[i].vs0 = *(const GAS bf16x8*)(&Vh[(size_t)((k0) + sr) * KVW + sc]); sr_[i].vs1 = *(const GAS bf16x8*)(&Vh[(size_t)((k0) + 32 + sr) * KVW + sc]); \
    sr_[i].ks0 = *(const GAS bf16x8*)(&Kh[(size_t)((k0) + sr) * KVW + sc]); sr_[i].ks1 = *(const GAS bf16x8*)(&Kh[(size_t)((k0) + 32 + sr) * KVW + sc]); } while (0)
#define SWRITE(b, i) do { *(LAS bf16x8*)(V_lds + (b) * SHM_V + vst0) = sr_[i].vs0;          \
    *(LAS bf16x8*)(V_lds + (b) * SHM_V + vst1) = sr_[i].vs1; int kc = sc * 2;               \
    *(LAS bf16x8*)(K_lds + (b) * SHM_K + KSWZ(sr, kc)) = sr_[i].ks0;                       \
    *(LAS bf16x8*)(K_lds + (b) * SHM_K + KSWZ(32 + sr, kc)) = sr_[i].ks1; } while (0)
#define SWAIT() do { if constexpr (SDEPTH == 2) asm volatile("s_waitcnt vmcnt(4)" ::: "memory"); else asm volatile("s_waitcnt vmcnt(0)" ::: "memory"); } while (0)
#define RESC(a) do { if (__any((a) < 1.f)) { if (hi == 0) al_l[r32] = (a); asm volatile("s_waitcnt lgkmcnt(0)" ::: "memory"); \
    _Pragma("unroll") for (int d = 0; d < 4; ++d) _Pragma("unroll") for (int r = 0; r < 16; ++r) o[d][r] *= al_l[crow(r, hi)]; } } while (0)
  f32x16 pA0, pA1, pB0, pB1; float mnA, mnB, alA, alB; bf16x8 pa0, pa1, pa2, pa3;
  constexpr int SE = 0, SO = SDEPTH - 1;
  bool sA = SKIPT(kt_lo), sB = false;
  SLOAD(SE, 0); asm volatile("s_waitcnt vmcnt(0)" ::: "memory"); SWRITE(0, SE); __syncthreads();
  if (!sA) { qkt(pA0, pA1, K_lds, qr, r32, hi); if (MASKT(kt_lo)) band_mask(pA0, pA1, kt_lo, qi, hi); partialSM(pA0, pA1, m_reg, mnA, alA); } else alA = 1.f;
  SLOAD(SO, KVBLK); if constexpr (SDEPTH == 2) { if (2 < NT) SLOAD(SE, 2 * KVBLK); }
  SWAIT(); SWRITE(1, SO); __syncthreads();
  for (int j = 1; j + 1 < NT; j += 2) {
    sB = SKIPT(kt_lo + j);
    SBAR(); if (!sB) { qkt(pB0, pB1, K_lds + SHM_K, qr, r32, hi); if (MASKT(kt_lo + j)) band_mask(pB0, pB1, kt_lo + j, qi, hi); }
    if (!sA) finishSM(pA0, pA1, alA, l_reg, pa0, pa1, pa2, pa3); SBAR();
    SLOAD(SO, (j + SDEPTH) * KVBLK); SBAR();
    if (!sA) pv_d0(o, vb0, pa0, pa1, pa2, pa3);
    if (!sB) partialSM(pB0, pB1, m_reg, mnB, alB); else alB = 1.f;
    __syncthreads(); SWAIT(); SWRITE(0, SE);
    RESC(alB); __syncthreads();
    sA = SKIPT(kt_lo + j + 1);
    SBAR(); if (!sA) { qkt(pA0, pA1, K_lds, qr, r32, hi); if (MASKT(kt_lo + j + 1)) band_mask(pA0, pA1, kt_lo + j + 1, qi, hi); }
    if (!sB) finishSM(pB0, pB1, alB, l_reg, pa0, pa1, pa2, pa3); SBAR();
    if (SDEPTH == 1 || j + 3 < NT) SLOAD(SE, (j + 1 + SDEPTH) * KVBLK); SBAR();
    if (!sB) pv_d0(o, vb0 + SHM_V, pa0, pa1, pa2, pa3);
    if (!sA) partialSM(pA0, pA1, m_reg, mnA, alA); else alA = 1.f;
    __syncthreads(); SWAIT(); SWRITE(1, SO);
    RESC(alA); __syncthreads();
  }
  sB = SKIPT(kt_lo + NT - 1);
  SBAR(); if (!sB) { qkt(pB0, pB1, K_lds + SHM_K, qr, r32, hi); if (MASKT(kt_lo + NT - 1)) band_mask(pB0, pB1, kt_lo + NT - 1, qi, hi); }
  if (!sA) finishSM(pA0, pA1, alA, l_reg, pa0, pa1, pa2, pa3); SBAR();
  if (!sA) pv_d0(o, vb0, pa0, pa1, pa2, pa3);
  if (!sB) partialSM(pB0, pB1, m_reg, mnB, alB); else alB = 1.f;
  __syncthreads(); RESC(alB);
  if (!sB) { finishSM(pB0, pB1, alB, l_reg, pa0, pa1, pa2, pa3); SBAR();
    pv_d0(o, vb0 + SHM_V, pa0, pa1, pa2, pa3); }
  { constexpr float C = SCALE * 1.4426950408889634f; l_reg += __builtin_amdgcn_exp2f(sink16[hq] * 1.4426950408889634f - m_reg * C); }
  if (hi == 0) li_l[r32] = l_reg; asm volatile("s_waitcnt lgkmcnt(0)" ::: "memory");
  float rli[16];
#pragma unroll
  for (int r = 0; r < 16; ++r) rli[r] = __builtin_amdgcn_rcpf(li_l[crow(r, hi)]);
  gbf16* Ow = Oq + (size_t)(blk_row0 + qrel0) * D + hq * HD;
#pragma unroll
  for (int r = 0; r < 16; ++r) { const int orow = crow(r, hi);
#pragma unroll
    for (int d0 = 0; d0 < 4; ++d0) Ow[(size_t)orow * D + d0 * 32 + r32] = (bf16_t)(cvt_pk_bf16(o[d0][r] * rli[r], 0.f) & 0xffffu); }
#undef SLOAD
#undef SWRITE
#undef SWAIT
#undef RESC
#undef SKIPT
#undef MASKT
  __syncthreads();
}

__device__ __forceinline__ void sgu_stats_unit(const gbf16* SV, gf32* stats, int r0, int wave_s) {
  const int tid = make_tid(wave_s), wid = tid >> 6, lane = tid & 63;
#pragma unroll 1
  for (int rb = 0; rb < 16; rb += 4) {
    u32x4 w[4][4];
#pragma unroll
    for (int q = 0; q < 4; ++q)
#pragma unroll
      for (int j = 0; j < 4; ++j) w[q][j] = *(const GAS u32x4*)(SV + (size_t)(r0 + 16 * wid + rb + q) * D + lane * 8 + j * 512);
#pragma unroll
    for (int q = 0; q < 4; ++q) {
      float v[32];
#pragma unroll
      for (int j = 0; j < 4; ++j) { const u32x4 x = w[q][j];
        v[8 * j + 0] = bflo(x.x); v[8 * j + 1] = bfhi(x.x); v[8 * j + 2] = bflo(x.y); v[8 * j + 3] = bfhi(x.y); v[8 * j + 4] = bflo(x.z); v[8 * j + 5] = bfhi(x.z); v[8 * j + 6] = bflo(x.w); v[8 * j + 7] = bfhi(x.w); }
      float s = 0.f;
#pragma unroll
      for (int j = 0; j < 32; ++j) s += v[j];
      const float mean = wave_sum(s) * (1.0f / 2048.0f); float qq = 0.f;
#pragma unroll
      for (int j = 0; j < 32; ++j) { const float d = v[j] - mean; qq += d * d; }
      const float rstd = 1.0f / sqrtf(wave_sum(qq) * (1.0f / 2048.0f) + LN_EPS);
      if (lane == 0) *(GAS f32x2*)(stats + 2 * (size_t)(r0 + 16 * wid + rb + q)) = (f32x2){mean, rstd};
    }
  }
}

__device__ __forceinline__ void sgu_phase(const gbf16* SV, gbf16* U, gbf16* UO, const gf32* stats, const gbf16* swb  , const gf32* sb  ,
                                          const gf32* lng, const gf32* lnb, LAS char* lds, int wave_s, int G, int rev = 0) {
  const int tid = make_tid(wave_s), wid = tid >> 6, lane = tid & 63, r32 = lane & 31, hi = lane >> 5;
  const int sr = tid >> 4, sc = (tid & 15) * 8, k4 = (tid & 15) * 4;
  const int pb = wid & 3, dh = wid >> 2;
  constexpr int NU = 320 * 16, ZT_OFF = 65536, ZT_LD = 132;
  LAS float* Zt = (LAS float*)(lds + ZT_OFF);
  int idx = blockIdx.x;
  if (idx >= NU) return;
  u32x4 svr[4]; f32x2 str[4]; bf16x8 pan[8];
#define SGU_MAP(ix) (rev ? NU - 1 - (ix) : (ix))
#define SGU_ISSUE(ix) do { const int ch_ = SGU_MAP(ix) >> 4, g_ = SGU_MAP(ix) & 15, r0_ = ch_ * 128; \
    _Pragma("unroll") for (int i = 0; i < 4; ++i) { svr[i] = *(const GAS u32x4*)(SV + (size_t)(r0_ + sr + 32 * i) * D + g_ * 128 + sc); str[i] = *(const GAS f32x2*)(stats + 2 * (size_t)(r0_ + sr + 32 * i)); } \
    const gbf16* wp_ = swb + ((size_t)g_ * 128 + 32 * pb + r32) * 128 + 8 * hi; \
    _Pragma("unroll") for (int s = 0; s < 8; ++s) pan[s] = *(const GAS bf16x8*)(wp_ + 16 * s); } while (0)
  SGU_ISSUE(idx);
#pragma unroll 1
  for (int it = 0;; ++it) {
    const int g = SGU_MAP(idx) & 15, r0 = (SGU_MAP(idx) >> 4) * 128;
    LAS char* vbuf = lds + (it & 1) * 32768;
    { const f32x4 ga = *(const GAS f32x4*)(lng + g * 128 + sc), gb2 = *(const GAS f32x4*)(lng + g * 128 + sc + 4), ba = *(const GAS f32x4*)(lnb + g * 128 + sc), bb = *(const GAS f32x4*)(lnb + g * 128 + sc + 4);
#pragma unroll
      for (int i = 0; i < 4; ++i) { const int row = sr + 32 * i; const u32x4 w = svr[i]; const float mean = str[i].x, rstd = str[i].y;
        const float x[8] = { bflo(w.x), bfhi(w.x), bflo(w.y), bfhi(w.y), bflo(w.z), bfhi(w.z), bflo(w.w), bfhi(w.w) };
        float y[8];
#pragma unroll
        for (int e = 0; e < 4; ++e) { y[e] = (x[e] - mean) * rstd * ga[e] + ba[e]; y[4 + e] = (x[4 + e] - mean) * rstd * gb2[e] + bb[e]; }
        u32x4 ow; ow.x = cvt_pk_bf16(y[0], y[1]); ow.y = cvt_pk_bf16(y[2], y[3]); ow.z = cvt_pk_bf16(y[4], y[5]); ow.w = cvt_pk_bf16(y[6], y[7]);
        *(LAS u32x4*)(vbuf + (row >> 6) * SHM_V + v_st(row & 63, sc)) = ow; } }
    bf16x8 pa[8];
#pragma unroll
    for (int s = 0; s < 8; ++s) pa[s] = pan[s];
    u32x2 ur[4][2]; float bias[4];
#pragma unroll
    for (int j = 0; j < 4; ++j) { const gbf16* up = U + (size_t)(r0 + sr + 32 * j) * D + g * 128 + k4;
      ur[j][0] = *(const GAS u32x2*)up; ur[j][1] = *(const GAS u32x2*)(up + 64); bias[j] = sb[g * 128 + sr + 32 * j]; }
    const int nidx = idx + G; const bool has_next = nidx < NU;
    if (has_next) SGU_ISSUE(nidx);
    __syncthreads();
    const int vb0 = (int)(uintptr_t)vbuf + v_rd_base(lane) + dh * 1024;
    f32x16 o0 = {}, o1 = {};
    pv_one<0>(o0, vb0, pa[0], pa[1], pa[2], pa[3]); pv_one<1>(o1, vb0, pa[0], pa[1], pa[2], pa[3]);
    pv_one<0>(o0, vb0 + SHM_V, pa[4], pa[5], pa[6], pa[7]); pv_one<1>(o1, vb0 + SHM_V, pa[4], pa[5], pa[6], pa[7]);
#pragma unroll
    for (int r = 0; r < 16; ++r) { const int p = 32 * pb + crow(r, hi);
      Zt[p * ZT_LD + 64 * dh + r32] = o0[r]; Zt[p * ZT_LD + 64 * dh + 32 + r32] = o1[r]; }
    __syncthreads();
#pragma unroll
    for (int j = 0; j < 4; ++j) { const int row = sr + 32 * j; gbf16* up = UO + (size_t)(r0 + row) * D + g * 128 + k4;
#pragma unroll
      for (int h = 0; h < 2; ++h) { const f32x4 z = *(const LAS f32x4*)(Zt + row * ZT_LD + 64 * h + k4); const u32x2 uw = ur[j][h];
        u32x2 ow; ow.x = cvt_pk_bf16(bflo(uw.x) * (z[0] + bias[j]), bfhi(uw.x) * (z[1] + bias[j])); ow.y = cvt_pk_bf16(bflo(uw.y) * (z[2] + bias[j]), bfhi(uw.y) * (z[3] + bias[j]));
        *(GAS u32x2*)(up + 64 * h) = ow; } }
    if (!has_next) break;
    idx = nidx;
  }
#undef SGU_ISSUE
#undef SGU_MAP
  __syncthreads();
}
#undef KSWZ
#undef SBAR
}

#define XB_TMO      128
#define XB_XCNT(j)  (256  + 64 * (j))
#define XB_XSUB(j)  (1280 + 64 * (j))
#define XB_XGEN(j)  (2304 + 64 * (j))
#define XB_TOP      3328
#define XB_TOPGEN   3392
#define XCD_BAR_WORDS 3456
#define XB_SPIN_CAP (1u << 20)
__device__ __forceinline__ unsigned xb_ld(unsigned* p)              { return __hip_atomic_load(p, __ATOMIC_RELAXED, __HIP_MEMORY_SCOPE_AGENT); }
__device__ __forceinline__ unsigned xb_add(unsigned* p, unsigned v) { return __hip_atomic_fetch_add(p, v, __ATOMIC_RELAXED, __HIP_MEMORY_SCOPE_AGENT); }
__device__ __forceinline__ unsigned xb_xcc_id() { return (unsigned)__builtin_amdgcn_s_getreg((3 << 11) | 20) & 0xFu; }
#define XB_SPIN(cond, bar) do { unsigned _sp = 0; while (cond) { __builtin_amdgcn_s_sleep(1); \
    if ((++_sp & 255u) == 0u) { if (xb_ld(&(bar)[XB_TMO])) break; if (_sp > XB_SPIN_CAP) { atomicAdd(&(bar)[XB_TMO], 1u); break; } } } } while (0)
struct XcdBarrier { unsigned* bar; unsigned x; volatile LAS unsigned* st; };
__device__ __forceinline__ XcdBarrier xcd_barrier_post(unsigned* bar, volatile LAS unsigned* st) {
    XcdBarrier b; b.bar = bar; b.x = xb_xcc_id(); b.st = st;
    if (make_tid(wg_wave_index()) == 0) (void)xb_add(&bar[XB_XCNT(b.x)], 1u);
    return b;
}
__device__ __forceinline__ void xcd_barrier_complete(unsigned* bar, unsigned x, unsigned& nloc, unsigned& nx) {
    const unsigned G = gridDim.x * gridDim.y * gridDim.z;
    unsigned sum, cnt, mine, sp = 0u;
    for (;;) {
        sum = 0u; cnt = 0u; mine = 0u;
#pragma unroll 1
        for (unsigned j = 0; j < 16; ++j) { const unsigned c = xb_ld(&bar[XB_XCNT(j)]); sum += c; cnt += (c > 0u) ? 1u : 0u; mine = (j == x) ? c : mine; }
        if (sum == G) break;
        __builtin_amdgcn_s_sleep(1);
        if ((++sp & 255u) == 0u) { if (xb_ld(&bar[XB_TMO])) break; if (sp > XB_SPIN_CAP) { atomicAdd(&bar[XB_TMO], 1u); break; } }
    }
    nloc = mine > 0u ? mine : 1u; nx = cnt > 0u ? cnt : 1u;
}
__device__ __forceinline__ void xcd_barrier(const XcdBarrier& b, int wave_s) {
    asm volatile("s_waitcnt vmcnt(0)" ::: "memory");
    __syncthreads();
    if (make_tid(wave_s) == 0) {
        unsigned* bar = b.bar; asm volatile("" : "+s"(bar));
        __builtin_amdgcn_s_waitcnt(0);
        unsigned nloc = b.st[0], nx = b.st[1];
        if (nloc == 0u) { xcd_barrier_complete(bar, b.x, nloc, nx); b.st[0] = nloc; b.st[1] = nx; }
        const unsigned old = xb_add(&bar[XB_XSUB(b.x)], 1u);
        const unsigned gen = old / nloc;
        if (old + 1u == (gen + 1u) * nloc) {
            __builtin_amdgcn_fence(__ATOMIC_RELEASE, "agent");
            asm volatile("s_waitcnt vmcnt(0)" ::: "memory");
            const unsigned og = xb_add(&bar[XB_TOP], 1u);
            const unsigned tg = og / nx;
            if (og + 1u == (tg + 1u) * nx) xb_add(&bar[XB_TOPGEN], 1u);
            else XB_SPIN(xb_ld(&bar[XB_TOPGEN]) == tg, bar);
            __builtin_amdgcn_fence(__ATOMIC_ACQUIRE, "agent");
            xb_add(&bar[XB_XGEN(b.x)], 1u);
            asm volatile("s_waitcnt vmcnt(0)" ::: "memory");
        } else {
            XB_SPIN(xb_ld(&bar[XB_XGEN(b.x)]) == gen, bar);
            __builtin_amdgcn_fence(__ATOMIC_ACQUIRE, "agent");
            asm volatile("s_waitcnt vmcnt(0)" ::: "memory");
        }
    }
    __syncthreads();
}

struct Params {
    const float* x_prompt; const float* x_sample; const float* c_prompt; const float* c_sample;
    const float* w_ada; const float* b_ada; const float* ln_g; const float* ln_b;
    const float* ffn1_w_in; const float* ffn1_w_out; const float* w_mix_in; const float* attn_sink;
    const float* sgu_ln_g; const float* sgu_ln_b; const float* sgu_w; const float* sgu_b;
    const float* w_br_attn; const float* w_br_sgu; const float* w_mix_out; const float* ffn2_w_in; const float* ffn2_w_out;
    float* out; unsigned char* ws;
    float inv_freq[64];
    int ph_lo, ph_hi;
};

__device__ __forceinline__ int srcmap(int kind, int n) {
    if (kind == 0) return n;
    if (kind == 1) { const int t = n >> 8, j = n & 255; return j < 128 ? 128 * t + j : DFF + 128 * t + (j - 128); }
    if (n < ZU) return OFF_Q + (n & ~127) + dperm(n & 127);
    if (n < ZSV) return OFF_U + (n - ZU);
    if (n < ZGA) return OFF_SV + (n - ZSV);
    if (n < ZGB) return OFF_GA + (n - ZGA);
    if (n < ZK) return OFF_GB + (n - ZGB);
    if (n < ZV) { const int m = n - ZK; return OFF_K + (m & ~127) + dperm(m & 127); }
    return OFF_V + (n - ZV);
}
struct CvItem { const gf32* W; gbf16* WT; int K, N, kind, item, ldk; };
__device__ __forceinline__ void cv_load(const CvItem& c, int lane, float (&wv)[32]) {
    const int nblk = c.N / 32, kb = c.item / nblk, nb = c.item % nblk, k0 = 64 * kb, n0 = 32 * nb;
    const int scol = srcmap(c.kind, n0 + (lane & 31));
#pragma unroll
    for (int i = 0; i < 32; ++i) wv[i] = c.W[(size_t)(k0 + 2 * i + (lane >> 5)) * c.N + scol];
}
__device__ __forceinline__ void cv_store(const CvItem& c, int lane, LAS float* scr, const float (&wv)[32]) {
    const int nblk = c.N / 32, kb = c.item / nblk, nb = c.item % nblk, k0 = 64 * kb, n0 = 32 * nb;
#pragma unroll
    for (int i = 0; i < 32; ++i) scr[(2 * i + (lane >> 5)) * 33 + (lane & 31)] = wv[i];
    asm volatile("s_waitcnt lgkmcnt(0)" ::: "memory");
    const int cc = lane & 7;
    const float wsc = (c.kind == 1) ? (((n0 & 255) < 128) ? 1.4426950408889634f : 0.6931471805599453f) : ((c.kind == 2 && n0 >= ZGA && n0 < ZK) ? 1.4426950408889634f : 1.0f);
#pragma unroll
    for (int j = 0; j < 4; ++j) { const int n = (lane >> 3) + 8 * j; const LAS float* s = scr + (8 * cc) * 33 + n;
        u32x4 o; o.x = cvt_pk_bf16(s[0 * 33] * wsc, s[1 * 33] * wsc); o.y = cvt_pk_bf16(s[2 * 33] * wsc, s[3 * 33] * wsc); o.z = cvt_pk_bf16(s[4 * 33] * wsc, s[5 * 33] * wsc); o.w = cvt_pk_bf16(s[6 * 33] * wsc, s[7 * 33] * wsc);
        *(GAS u32x4*)(c.WT + (size_t)(n0 + n) * c.ldk + k0 + 8 * cc) = o; }
    asm volatile("s_waitcnt lgkmcnt(0)" ::: "memory");
}
__device__ __forceinline__ void cv_decode(const Params& P, int l, gbf16* wt, int it, CvItem& c) {
    constexpr int I_FIN = (D / 64) * (NIN / 32), I_FOUT = (DFF / 64) * (D / 32), I_SQ = (D / 64) * (D / 32);
    int r = it;
    if (r < I_FIN) { c = CvItem{(const gf32*)P.ffn1_w_in + (size_t)l * D * NIN, wt + WT_FFN1_IN / 2, D, NIN, 1, r, D}; return; } r -= I_FIN;
    if (r < I_FOUT) { c = CvItem{(const gf32*)P.ffn1_w_out + (size_t)l * DFF * D, wt + WT_FFN1_OUT / 2, DFF, D, 0, r, DFF}; return; } r -= I_FOUT;
    if (r < I_FIN) { c = CvItem{(const gf32*)P.w_mix_in + (size_t)l * D * NIN, wt + WT_MIX_IN / 2, D, NIN, 2, r, D}; return; } r -= I_FIN;
    if (r < I_SQ) { c = CvItem{(const gf32*)P.w_br_attn + (size_t)l * D * D, wt + WT_BRA / 2, D, D, 0, r, 2 * D}; return; } r -= I_SQ;
    if (r < I_SQ) { c = CvItem{(const gf32*)P.w_br_sgu + (size_t)l * D * D, wt + WT_BRA / 2 + D, D, D, 0, r, 2 * D}; return; } r -= I_SQ;
    if (r < I_SQ) { c = CvItem{(const gf32*)P.w_mix_out + (size_t)l * D * D, wt + WT_MO / 2, D, D, 0, r, D}; return; } r -= I_SQ;
    if (r < I_FIN) { c = CvItem{(const gf32*)P.ffn2_w_in + (size_t)l * D * NIN, wt + WT_FFN2_IN / 2, D, NIN, 1, r, D}; return; } r -= I_FIN;
    c = CvItem{(const gf32*)P.ffn2_w_out + (size_t)l * DFF * D, wt + WT_FFN2_OUT / 2, DFF, D, 0, r, DFF};
}
#ifndef CV_TAIL_PCT
#define CV_TAIL_PCT 60
#endif
__device__ __forceinline__ void convert_group(const Params& P, int l, int grp, int part, LAS unsigned char* lds, int wave_s, int worker, int nworkers) {
    const int tid_ = make_tid(wave_s);
    const int lane = tid_ & 63, wave = __builtin_amdgcn_readfirstlane(tid_ >> 6), gw = worker * 8 + wave, NGW = nworkers * 8;
    LAS float* scr = (LAS float*)(lds + wave * 8704);
    gu8* wsb = (gu8*)P.ws; asm volatile("" : "+s"(wsb));
    gbf16* wt = (gbf16*)(wsb + WS_WT);
    constexpr int I_FIN = (D / 64) * (NIN / 32), I_FOUT = (DFF / 64) * (D / 32), I_SQ = (D / 64) * (D / 32);
    constexpr int E1 = I_FIN + I_FOUT, E2 = E1 + I_FIN + 3 * I_SQ, E3 = E2 + I_FIN + I_FOUT;
    const int g_lo = grp == 1 ? 0 : grp == 2 ? E1 : E2, g_hi = grp == 1 ? E1 : grp == 2 ? E2 : E3;
    const int cut = g_lo + (int)((long)(g_hi - g_lo) * CV_TAIL_PCT / 100);
    const int it_lo = part < 0 ? g_lo : part == 0 ? g_lo : cut, it_hi = part < 0 ? g_hi : part == 0 ? cut : g_hi;
    int it = it_lo + gw; if (it >= it_hi) return;
    CvItem cur, nxt; float wvn[32];
    cv_decode(P, l, wt, it, cur); cv_load(cur, lane, wvn);
#pragma unroll 1
    for (;;) {
        float wv[32];
#pragma unroll
        for (int i = 0; i < 32; ++i) wv[i] = wvn[i];
        const int itn = it + NGW; const bool has_next = itn < it_hi;
        if (has_next) { cv_decode(P, l, wt, itn, nxt); cv_load(nxt, lane, wvn); }
        cv_store(cur, lane, scr, wv);
        if (!has_next) break;
        cur = nxt; it = itn;
    }
}
__device__ __forceinline__ void convert_in_tail(const Params& P, int l, int grp, LAS unsigned char* lds, int wave_s, int G, int c) {
    constexpr int nwg = (M / 256) * (NIN / 256);
    const int rem = nwg % G;
    if (rem == 0) convert_group(P, l, grp, 0, lds, wave_s, c, G);
    else if (c >= rem) convert_group(P, l, grp, 0, lds, wave_s, c - rem, G - rem);
}
__device__ __forceinline__ void sincos_d(double x, double& s, double& c) {
    const double q = rint(x * 0.63661977236758134308);
    double r = fma(-q, 1.57079632673412561417e+00, x); r = fma(-q, 6.07710050650619224932e-11, r);
    const double r2 = r * r;
    const double sp = r + r * r2 * (-1.66666666666666324348e-01 + r2 * (8.33333333332248946124e-03 + r2 * (-1.98412698298579493134e-04 + r2 * (2.75573137070700676789e-06 + r2 * (-2.50507602534068634195e-08 + r2 * 1.58969099521155010221e-10)))));
    const double cp = 1.0 - 0.5 * r2 + r2 * r2 * (4.16666666666666019037e-02 + r2 * (-1.38888888888741095749e-03 + r2 * (2.48015872894767294178e-05 + r2 * (-2.75573143513906633035e-07 + r2 * (2.08757232129817482790e-09 + r2 * -1.13596475577881948265e-11)))));
    const int n = ((int)q) & 3;
    s = (n == 0) ? sp : (n == 1) ? cp : (n == 2) ? -sp : -cp;
    c = (n == 0) ? cp : (n == 1) ? -sp : (n == 2) ? -cp : sp;
}

template <int MODE>
__device__ __forceinline__ void row_phase(const Params& P, LAS unsigned char* lds, const gf32* lng, const gf32* lnb, const gf32* modl_  , int jshift, int wave_s, int rev = 0) {
    const int tid = make_tid(wave_s), lane = tid & 63, wave = __builtin_amdgcn_readfirstlane(tid >> 6);
    LAS float* G = (LAS float*)lds; LAS float* Bv = G + 2048; LAS float* SC = Bv + 2048; LAS float* SH = SC + 2048;
    gu8* wsb = (gu8*)P.ws; gf32* xout = (gf32*)P.out; asm volatile("" : "+s"(wsb), "+s"(xout));
    gbf16* hbuf = (gbf16*)(wsb + WS_H); gf32* rsb = (gf32*)(wsb + WS_RS); const GAS unsigned short* ybuf = (const GAS unsigned short*)(wsb + WS_Y);
    __syncthreads();
    if (MODE != 0) { for (int i = tid; i < 2048; i += 512) { G[i] = lng[i]; Bv[i] = lnb[i]; } }
    int curb = -1;
    constexpr int NL = (MODE == 0) ? 8 : 4;
    u32x4 nv[NL], nv2[NL];
#define ROW_TT(q_) ((int)blockIdx.x + ((q_) >> 2) * (int)gridDim.x)
#define ROW_AT(q_) (ROW_TT(q_) < M / 32 ? ((rev ? (M / 32 - 1 - ROW_TT(q_)) : ROW_TT(q_)) * 32 + wave * 4 + ((q_) & 3)) : M)
#define ROW_LOAD(dst, row_) do { if (MODE == 0) { const gf32* src_ = ((row_) < MP) ? (const gf32*)P.x_prompt + (size_t)(row_) * D : (const gf32*)P.x_sample + (size_t)((row_) - MP) * D; \
        _Pragma("unroll") for (int j = 0; j < NL; ++j) dst[j] = *(const GAS u32x4*)(src_ + 4 * (lane + 64 * j)); } \
      else { const GAS unsigned short* src_ = ybuf + (size_t)(row_) * D; _Pragma("unroll") for (int j = 0; j < NL; ++j) dst[j] = *(const GAS u32x4*)(src_ + 8 * (lane + 64 * j)); } } while (0)
    { const int r0_ = ROW_AT(0), r1_ = ROW_AT(1); if (r0_ < M) ROW_LOAD(nv, r0_); if (r1_ < M) ROW_LOAD(nv2, r1_); }
    int qidx = 0;
    for (int t = blockIdx.x; t < M / 32; t += gridDim.x) {
        const int row0 = (rev ? (M / 32 - 1 - t) : t) * 32, b = batch_of(row0);
        if (b != curb) {
            __syncthreads();
            if (MODE != 2) { const gf32* sh = modl_ + ((size_t)b * NMOD + jshift) * D; const gf32* sc = sh + D;
                for (int i = tid; i < 2048; i += 512) { SH[i] = sh[i]; SC[i] = 1.0f + sc[i]; } }
            __syncthreads(); curb = b;
        }
#pragma unroll 1
        for (int rr = 0; rr < 4; ++rr, ++qidx) {
            const int row = row0 + wave * 4 + rr;
            u32x4 cw[NL];
#pragma unroll
            for (int j = 0; j < NL; ++j) { cw[j] = nv[j]; nv[j] = nv2[j]; }
            { const int nrow = ROW_AT(qidx + 2); if (nrow < M) ROW_LOAD(nv2, nrow); }
            f32x4 v[8];
            if (MODE == 0) {
#pragma unroll
                for (int j = 0; j < 8; ++j) v[j] = __builtin_bit_cast(f32x4, cw[j]);
            } else {
#pragma unroll
                for (int j = 0; j < 4; ++j) { v[2 * j] = (f32x4){f16lo(cw[j].x), f16hi(cw[j].x), f16lo(cw[j].y), f16hi(cw[j].y)}; v[2 * j + 1] = (f32x4){f16lo(cw[j].z), f16hi(cw[j].z), f16lo(cw[j].w), f16hi(cw[j].w)}; }
            }
#define CBASE(jj) ((MODE == 0) ? 4 * (lane + 64 * (jj)) : 8 * (lane + 64 * ((jj) >> 1)) + 4 * ((jj) & 1))
            if (MODE != 0) {
                float s = 0.f;
#pragma unroll
                for (int j = 0; j < 8; ++j) s += (v[j][0] + v[j][1]) + (v[j][2] + v[j][3]);
                const float mean = wave_sum(s) * (1.0f / D); float q = 0.f;
#pragma unroll
                for (int j = 0; j < 8; ++j) { v[j] = v[j] - mean; q += (v[j][0] * v[j][0] + v[j][1] * v[j][1]) + (v[j][2] * v[j][2] + v[j][3] * v[j][3]); }
                const float rstd = 1.0f / sqrtf(wave_sum(q) * (1.0f / D) + LN_EPS);
                if (MODE == 1 && lane == 0) *(GAS f32x2*)(rsb + 2 * (size_t)row) = (f32x2){mean, rstd};
#pragma unroll
                for (int j = 0; j < 8; ++j) { const int c = CBASE(j);
                    const f32x4 gg = *(const LAS f32x4*)(G + c), bb = *(const LAS f32x4*)(Bv + c);
                    v[j] = v[j] * rstd * gg + bb;
                    if (MODE == 2) *(GAS f32x4*)(xout + (size_t)row * D + c) = v[j]; }
            }
            if (MODE != 2) {
                if (MODE == 0) {
#pragma unroll
                    for (int j = 0; j < 8; ++j) { const int c = CBASE(j);
                        const f32x4 sc = *(const LAS f32x4*)(SC + c), sh = *(const LAS f32x4*)(SH + c);
                        const f32x4 h = v[j] * sc + sh;
                        u32x2 w; w.x = cvt_pk_bf16(h[0], h[1]); w.y = cvt_pk_bf16(h[2], h[3]);
                        *(GAS u32x2*)(hbuf + (size_t)row * D + c) = w; }
                } else {
#pragma unroll
                    for (int j = 0; j < 4; ++j) { const int c = CBASE(2 * j);
                        const f32x4 sc0 = *(const LAS f32x4*)(SC + c), sh0 = *(const LAS f32x4*)(SH + c), sc1 = *(const LAS f32x4*)(SC + c + 4), sh1 = *(const LAS f32x4*)(SH + c + 4);
                        const f32x4 h0 = v[2 * j] * sc0 + sh0, h1 = v[2 * j + 1] * sc1 + sh1;
                        u32x4 w; w.x = cvt_pk_bf16(h0[0], h0[1]); w.y = cvt_pk_bf16(h0[2], h0[3]); w.z = cvt_pk_bf16(h1[0], h1[1]); w.w = cvt_pk_bf16(h1[2], h1[3]);
                        *(GAS u32x4*)(hbuf + (size_t)row * D + c) = w; }
                }
            }
#undef CBASE
        }
    }
#undef ROW_AT
#undef ROW_TT
#undef ROW_LOAD
    __syncthreads();
}

__global__ void __launch_bounds__(512, 2) hybrid_fwd(Params P) {
    extern __shared__ __attribute__((aligned(16))) unsigned char lds_raw[];
    LAS unsigned char* lds = (LAS unsigned char*)lds_raw;
    const int G = gridDim.x;
    const int wave_s_ = wg_wave_index();
    volatile LAS unsigned* MISC = (volatile LAS unsigned*)(lds + MISC_OFF);
    { const int t0 = make_tid(wave_s_); if (t0 < 8) MISC[t0] = 0u; }
    __syncthreads();
    unsigned* ctl = (unsigned*)(P.ws + WS_CTL);
    XcdBarrier bar; bar.bar = ctl + CW_BAR; bar.x = 0; bar.st = MISC;
    if (!MK_PER_PHASE) bar = xcd_barrier_post(ctl + CW_BAR, MISC);
    const int lo = P.ph_lo, hi = P.ph_hi;
    int ph = 0, dirx = 1;
#ifndef PHMASK
#define PHMASK 0xFFFFF
#endif
#define SITE(id) (((PHMASK) >> (id)) & 1)
#define PH_ON (ph >= lo && ph < hi)
#define PH_REV (dirx)
#define PH_END do { if (!MK_PER_PHASE && ph + 1 < hi) xcd_barrier(bar, wave_s_); } while (0)
#define PH_LOCALS gu8* wsb = (gu8*)P.ws; int wv = wave_s_; asm volatile("" : "+s"(wsb), "+s"(wv)); const int wave_s = wv; \
    gf32* mod = (gf32*)(wsb + WS_MOD); gf32* cosT = (gf32*)(wsb + WS_COS); gf32* sinT = (gf32*)(wsb + WS_SIN); gbf16* swb = (gbf16*)(wsb + WS_SW); gf32* stats = (gf32*)(wsb + WS_ST); \
    gbf16* wt = (gbf16*)(wsb + WS_WT); gbf16* hbuf = (gbf16*)(wsb + WS_H); gbf16* zbuf = (gbf16*)(wsb + WS_Z); \
    (void)mod; (void)cosT; (void)sinT; (void)swb; (void)wt; (void)hbuf; (void)zbuf; (void)wave_s; (void)stats;
#define modl (mod + (size_t)l * NB * NMOD * D)

    if (SITE(0) && PH_ON) { PH_LOCALS
        convert_group(P, 0, 1, -1, lds, wave_s, (int)blockIdx.x, G);
        const int tid = make_tid(wave_s), lane = tid & 63, wave = __builtin_amdgcn_readfirstlane(tid >> 6);
        const int gt = blockIdx.x * 512 + tid, NGT = G * 512;
#pragma unroll 1
        for (int rep = DUP(9) ? 0 : 1; rep < 2; ++rep) {
        for (int i = gt; i < DEPTH * 16 * 128 * 128 / 2; i += NGT) { const f32x2 v = *(const GAS f32x2*)((const gf32*)P.sgu_w + 2 * (size_t)i); ((GAS unsigned*)swb)[i] = cvt_pk_bf16(v.x, v.y); }
        for (int i = gt; i < 8192 * 64; i += NGT) { const int pos = i >> 6, j = i & 63; const float ang = (float)pos * P.inv_freq[j]; double s, c; sincos_d((double)ang, s, c); cosT[i] = (float)c; sinT[i] = (float)s; }
        __syncthreads();
        LAS float* scv = (LAS float*)lds;
        LAS float* red = (LAS float*)(lds + 49152);
        for (int i = tid; i < NB * D; i += 512) { const int b = i >> 11, k = i & 2047; const float cv = (b < 2) ? ((const gf32*)P.c_prompt)[b * D + k] : ((const gf32*)P.c_sample)[(b - 2) * D + k]; scv[i] = silu_f(cv); }
        __syncthreads();
        constexpr int NCH = NMOD * D / 64;
        for (int it = blockIdx.x; it < DEPTH * NCH; it += G) {
            const int l = it / NCH, ch = it % NCH; const gf32* wp = (const gf32*)P.w_ada + (size_t)l * D * (NMOD * D) + (size_t)(256 * wave) * (NMOD * D) + ch * 64 + lane;
            float a[NB] = {0.f, 0.f, 0.f, 0.f, 0.f, 0.f};
#pragma unroll 1
            for (int k0 = 0; k0 < 256; k0 += 32) { float wv[32];
#pragma unroll
                for (int k = 0; k < 32; ++k) wv[k] = wp[(size_t)(k0 + k) * (NMOD * D)];
#pragma unroll
                for (int k = 0; k < 32; ++k)
#pragma unroll
                    for (int b = 0; b < NB; ++b) a[b] += scv[b * D + 256 * wave + k0 + k] * wv[k]; }
#pragma unroll
            for (int b = 0; b < NB; ++b) red[(wave * NB + b) * 64 + lane] = a[b];
            __syncthreads();
            if (tid < NB * 64) { const int b = tid >> 6, c = tid & 63; float s = 0.f;
#pragma unroll
                for (int w = 0; w < 8; ++w) s += red[(w * NB + b) * 64 + c];
                const int n = ch * 64 + c; mod[((size_t)l * NB + b) * (NMOD * D) + n] = s + ((const gf32*)P.b_ada)[(size_t)l * NMOD * D + n]; }
            __syncthreads();
        }
        if (rep == 0) xcd_barrier(bar, wave_s_); }
        PH_END;
    }
    ++ph; dirx ^= 1;
    if (SITE(1) && PH_ON) { PH_LOCALS row_phase<0>(P, lds, nullptr, nullptr, mod, 0, wave_s); if (DUP(1)) { xcd_barrier(bar, wave_s_); row_phase<0>(P, lds, nullptr, nullptr, mod, 0, wave_s); } PH_END; }
    ++ph; dirx ^= 1;

    for (int l = 0; l < DEPTH; ++l) {
        for (int half = 0; half < 2; ++half) {
            const int sub = 2 * half;
            if (SITE(2) && PH_ON) { PH_LOCALS
                pg8::Gemm g{hbuf, wt + (half ? WT_FFN2_IN : WT_FFN1_IN) / 2}; pg8::StaticOrder<NIN> S; S.init(G, (int)blockIdx.x, PH_REV);
                pg8::EpiSwiglu E{zbuf};
                pg8::gemm_phase<pg8::EpiSwiglu, NIN, D, D, true, true>(lds, g, S, E, wave_s);
                if (half == 0) convert_in_tail(P, l, 2, lds, wave_s, G, (int)blockIdx.x);
                else if (l + 1 < DEPTH) convert_in_tail(P, l + 1, 1, lds, wave_s, G, (int)blockIdx.x);
                if (DUP(2)) { xcd_barrier(bar, wave_s_); pg8::gemm_phase<pg8::EpiSwiglu, NIN, D, D, true, true>(lds, g, S, E, wave_s); }
#ifdef PROBE_TILED
                { xcd_barrier(bar, wave_s_); pg8::EpiNone E0; pg8::gemm_phase<pg8::EpiNone, NIN, D, 64, true, true, 64, 32768, 32768>(lds, g, S, E0, wave_s); }
#endif
#ifdef PROBE_ROWMAJ
                { xcd_barrier(bar, wave_s_); pg8::EpiNone E0; pg8::gemm_phase<pg8::EpiNone, NIN, D, D, true, true>(lds, g, S, E0, wave_s); }
#endif
                PH_END;
            }
            ++ph; dirx ^= 1;
            if (SITE(3) && PH_ON) { PH_LOCALS
                pg8::Gemm g{zbuf, wt + (half ? WT_FFN2_OUT : WT_FFN1_OUT) / 2}; pg8::StaticOrder<D> S; S.init(G, (int)blockIdx.x, PH_REV);
                const bool first = (l == 0 && half == 0);
                GAS unsigned short* yb = (GAS unsigned short*)(wsb + WS_Y);
                if (DUP(3)) { pg8::EpiNone E0; pg8::gemm_phase<pg8::EpiNone, D, DFF, DFF, true, true>(lds, g, S, E0, wave_s); xcd_barrier(bar, wave_s_); }
                const int pl = half ? l : l - 1, psub = half ? 1 : 2;
                const gf32* plg = (const gf32*)P.ln_g + ((size_t)(first ? 0 : pl) * 3 + psub) * D; const gf32* plb = (const gf32*)P.ln_b + ((size_t)(first ? 0 : pl) * 3 + psub) * D;
                if (first) { pg8::EpiResid<0> E{(const gf32*)P.x_prompt, (const gf32*)P.x_sample, yb, modl + (size_t)(3 * sub + 2) * D, (const gf32*)(wsb + WS_RS), plg, plb, 0.5f};
                    pg8::gemm_phase<pg8::EpiResid<0>, D, DFF, DFF, true, true>(lds, g, S, E, wave_s); }
                else { pg8::EpiResid<1> E{(const gf32*)P.x_prompt, (const gf32*)P.x_sample, yb, modl + (size_t)(3 * sub + 2) * D, (const gf32*)(wsb + WS_RS), plg, plb, 0.5f};
                    pg8::gemm_phase<pg8::EpiResid<1>, D, DFF, DFF, true, true>(lds, g, S, E, wave_s); }
                PH_END;
            }
            ++ph; dirx ^= 1;
            if (SITE(4) && PH_ON) { PH_LOCALS
                const gf32* lg = (const gf32*)P.ln_g + ((size_t)l * 3 + sub) * D; const gf32* lb = (const gf32*)P.ln_b + ((size_t)l * 3 + sub) * D;
                if (DUP(4) && !(half == 1 && l + 1 >= DEPTH)) { if (half == 0) row_phase<1>(P, lds, lg, lb, modl, 3, wave_s); else row_phase<1>(P, lds, lg, lb, modl + (size_t)NB * NMOD * D, 0, wave_s); xcd_barrier(bar, wave_s_); }
                if (half == 0) { convert_group(P, l, 2, 1, lds, wave_s, (int)blockIdx.x, G); row_phase<1>(P, lds, lg, lb, modl, 3, wave_s, PH_REV); }
                else if (l + 1 < DEPTH) { convert_group(P, l + 1, 1, 1, lds, wave_s, (int)blockIdx.x, G); row_phase<1>(P, lds, lg, lb, modl + (size_t)NB * NMOD * D, 0, wave_s, PH_REV); }
                else row_phase<2>(P, lds, lg, lb, modl, 0, wave_s, PH_REV);
                PH_END;
            }
            ++ph; dirx ^= 1;
            if (half == 1) break;
            if (SITE(5) && PH_ON) { PH_LOCALS
                pg8::Gemm g{hbuf, wt + WT_MIX_IN / 2}; pg8::StaticOrder<NIN> S; S.init(G, (int)blockIdx.x, PH_REV);
                pg8::EpiMix E{zbuf, cosT, sinT, (gf32*)P.out};
                pg8::gemm_phase<pg8::EpiMix, NIN, D, D, true, true>(lds, g, S, E, wave_s);
                convert_in_tail(P, l, 3, lds, wave_s, G, (int)blockIdx.x);
                PH_END;
            }
            ++ph; dirx ^= 1;
            if (SITE(6) && PH_ON) { PH_LOCALS
                { const int tid = make_tid(wave_s); const gf32* sp = (const gf32*)P.out;
#pragma unroll 1
                  for (int r = blockIdx.x * 512 + tid; r < M; r += G * 512) { float s1 = 0.f, s2 = 0.f;
#pragma unroll
                      for (int j = 0; j < 16; ++j) { const f32x4 p = *(const GAS f32x4*)(sp + (size_t)r * 64 + 4 * j); s1 += p[0] + p[2]; s2 += p[1] + p[3]; }
                      const float mean = s1 * (1.0f / 2048.0f), var = fmaxf(s2 * (1.0f / 2048.0f) - mean * mean, 0.f);
                      *(GAS f32x2*)(stats + 2 * (size_t)r) = (f32x2){mean, 1.0f / sqrtf(var + LN_EPS)}; } }
#pragma unroll 1
                for (int rep = DUP(6) ? 0 : 1; rep < 2; ++rep) {
#pragma unroll 1
                for (int idx_ = blockIdx.x; idx_ < 2560; idx_ += G) {
                    const int idx = PH_REV ? 2559 - idx_ : idx_;
                    const int blk = idx >> 3, gk = (idx >> 1) & 3, hp = idx & 1; int seq_row0, nb, nblk;
                    if (blk < 64) { seq_row0 = (blk >> 5) * 4096; nb = blk & 31; nblk = 32; }
                    else { const int b2 = blk - 64; seq_row0 = MP + (b2 >> 6) * 8192; nb = b2 & 63; nblk = 64; }
                    att::attn_unit(zbuf + ZB_Q, (DUP(6) && rep == 0) ? hbuf : zbuf + ZB_Q, zbuf + ZB_K, zbuf + ZB_V, seq_row0, nb, nblk, gk, hp, (const gf32*)P.attn_sink + l * NHQ, (LAS char*)lds, wave_s);
                }
                if (rep == 0) xcd_barrier(bar, wave_s_); }
                PH_END;
            }
            ++ph;
            if (SITE(7) && PH_ON) { PH_LOCALS
                if (DUP(7)) { att::sgu_phase(zbuf + ZB_SV, zbuf + ZB_U, hbuf, stats, swb + (size_t)l * 16 * 128 * 128, (const gf32*)P.sgu_b + (size_t)l * 16 * 128, (const gf32*)P.sgu_ln_g + (size_t)l * D, (const gf32*)P.sgu_ln_b + (size_t)l * D, (LAS char*)lds, wave_s, G); xcd_barrier(bar, wave_s_); }
                att::sgu_phase(zbuf + ZB_SV, zbuf + ZB_U, zbuf + ZB_U, stats, swb + (size_t)l * 16 * 128 * 128, (const gf32*)P.sgu_b + (size_t)l * 16 * 128, (const gf32*)P.sgu_ln_g + (size_t)l * D, (const gf32*)P.sgu_ln_b + (size_t)l * D, (LAS char*)lds, wave_s, G, PH_REV);
                PH_END;
            }
            ++ph; dirx ^= 1;
            if (SITE(8) && PH_ON) { PH_LOCALS
                pg8::Gemm g{zbuf + ZB_Q, wt + WT_BRA / 2}; pg8::StaticOrder<D> S; S.init(G, (int)blockIdx.x, PH_REV);
                pg8::EpiBranchF E{hbuf, zbuf + ZB_GA, zbuf + ZB_GB};
                pg8::gemm_phase<pg8::EpiBranchF, D, 2 * D, D, true, true, 2 * D, 128, 128, 32, (size_t)M * D * 2 - 32 * 128>(lds, g, S, E, wave_s);
                PH_END;
            }
            ++ph; dirx ^= 1;
            if (SITE(10) && PH_ON) { PH_LOCALS
                pg8::Gemm g{hbuf, wt + WT_MO / 2}; pg8::StaticOrder<D> S; S.init(G, (int)blockIdx.x, PH_REV);
                GAS unsigned short* yb = (GAS unsigned short*)(wsb + WS_Y);
                pg8::EpiResid<1> E{(const gf32*)P.x_prompt, (const gf32*)P.x_sample, yb, modl + (size_t)(3 * 1 + 2) * D, (const gf32*)(wsb + WS_RS), (const gf32*)P.ln_g + ((size_t)l * 3 + 0) * D, (const gf32*)P.ln_b + ((size_t)l * 3 + 0) * D, 1.0f};
                pg8::gemm_phase<pg8::EpiResid<1>, D, D, D, true, true>(lds, g, S, E, wave_s);
                PH_END;
            }
            ++ph; dirx ^= 1;
            if (SITE(11) && PH_ON) { PH_LOCALS
                convert_group(P, l, 3, 1, lds, wave_s, (int)blockIdx.x, G);
                row_phase<1>(P, lds, (const gf32*)P.ln_g + ((size_t)l * 3 + 1) * D, (const gf32*)P.ln_b + ((size_t)l * 3 + 1) * D, modl, 6, wave_s, PH_REV);
                if (DUP(4)) { xcd_barrier(bar, wave_s_); row_phase<1>(P, lds, (const gf32*)P.ln_g + ((size_t)l * 3 + 1) * D, (const gf32*)P.ln_b + ((size_t)l * 3 + 1) * D, modl, 6, wave_s); }
                PH_END;
            }
            ++ph; dirx ^= 1;
        }
    }
#undef PH_ON
#undef PH_END
}

constexpr int N_PHASES = 2 + DEPTH * 12;

extern "C" void kernel_launch(void* const* d_in, const int* in_sizes, int n_in, void* d_out, int out_size, void* d_ws, size_t ws_size, hipStream_t stream) {
    static int grid = 0;
    if (grid == 0) {
        if (n_in != 21 || in_sizes[0] != MP * D || in_sizes[1] != MS * D || out_size != M * D || ws_size < WS_END) {
            fprintf(stderr, "kernel_launch: shape mismatch n_in %d in0 %d in1 %d out %d ws %zu (need %zu)\n", n_in, n_in > 0 ? in_sizes[0] : -1, n_in > 1 ? in_sizes[1] : -1, out_size, ws_size, (size_t)WS_END);
            grid = -1; return; }
        int dev = 0, cus = 0;
        if (hipGetDevice(&dev) != hipSuccess || hipDeviceGetAttribute(&cus, hipDeviceAttributeMultiprocessorCount, dev) != hipSuccess) { grid = -1; return; }
        if (hipFuncSetAttribute((const void*)hybrid_fwd, hipFuncAttributeMaxDynamicSharedMemorySize, LDS_BYTES) != hipSuccess) { fprintf(stderr, "kernel_launch: hipFuncSetAttribute failed\n"); grid = -1; return; }
        int per_cu = 0;
        if (hipOccupancyMaxActiveBlocksPerMultiprocessor(&per_cu, (const void*)hybrid_fwd, 512, LDS_BYTES) != hipSuccess || per_cu < 1) {
            fprintf(stderr, "kernel_launch: occupancy query reports %d blocks per CU\n", per_cu); }
        (void)hipGetLastError();
        grid = cus;
    }
    if (grid < 0) return;
    (void)hipMemsetAsync((char*)d_ws + WS_CTL, 0, CTL_ZERO_BYTES, stream);
    Params p{};
    p.x_prompt = (const float*)d_in[0]; p.x_sample = (const float*)d_in[1]; p.c_prompt = (const float*)d_in[2]; p.c_sample = (const float*)d_in[3];
    p.w_ada = (const float*)d_in[4]; p.b_ada = (const float*)d_in[5]; p.ln_g = (const float*)d_in[6]; p.ln_b = (const float*)d_in[7];
    p.ffn1_w_in = (const float*)d_in[8]; p.ffn1_w_out = (const float*)d_in[9]; p.w_mix_in = (const float*)d_in[10]; p.attn_sink = (const float*)d_in[11];
    p.sgu_ln_g = (const float*)d_in[12]; p.sgu_ln_b = (const float*)d_in[13]; p.sgu_w = (const float*)d_in[14]; p.sgu_b = (const float*)d_in[15];
    p.w_br_attn = (const float*)d_in[16]; p.w_br_sgu = (const float*)d_in[17]; p.w_mix_out = (const float*)d_in[18]; p.ffn2_w_in = (const float*)d_in[19]; p.ffn2_w_out = (const float*)d_in[20];
    p.out = (float*)d_out; p.ws = (unsigned char*)d_ws;
    for (int j = 0; j < 64; ++j) { const float t = powf(10000.0f, (float)j / 64.0f); p.inv_freq[j] = 1.0f / t; }
#if MK_PER_PHASE
    for (int k = 0; k < N_PHASES; ++k) { p.ph_lo = k; p.ph_hi = k + 1; hipLaunchKernelGGL(hybrid_fwd, dim3(grid), dim3(512), LDS_BYTES, stream, p); }
#else
#ifdef PROBE_FIRST
    p.ph_lo = 0; p.ph_hi = PROBE_K;
    hipLaunchKernelGGL(hybrid_fwd, dim3(grid), dim3(512), LDS_BYTES, stream, p);
    (void)hipMemsetAsync((char*)d_ws + WS_CTL, 0, CTL_ZERO_BYTES, stream);
#endif
    p.ph_lo = 0; p.ph_hi = N_PHASES;
    hipLaunchKernelGGL(hybrid_fwd, dim3(grid), dim3(512), LDS_BYTES, stream, p);
#ifdef PROBE_TWICE
    (void)hipMemsetAsync((char*)d_ws + WS_CTL, 0, CTL_ZERO_BYTES, stream);
    p.ph_lo = PROBE_LO; p.ph_hi = PROBE_HI;
    hipLaunchKernelGGL(hybrid_fwd, dim3(grid), dim3(512), LDS_BYTES, stream, p);
#endif
#endif
    const hipError_t le = hipPeekAtLastError();
    if (le != hipSuccess) fprintf(stderr, "kernel_launch: launch failed: %s\n", hipGetErrorName(le));
}
```
